# Optimizing an MI355X kernel written in HIP

```python
import jax, jax.numpy as jnp
from jax import lax
import numpy as np

D_MODEL = 2048
BATCH = 2
SEQ = 4096
DEPTH = 4

HEAD_DIM = 128
POOL_GROUPS = 4
POOL_WINDOWS = (2, 4, 8, 16)
D_POOL = POOL_GROUPS * HEAD_DIM
N_ATTN_HEADS = 8
D_ATTN = N_ATTN_HEADS * HEAD_DIM
N_IDX_HEADS = 16
D_IDX = 64
TOPK_MAX = 256
Q_BLOCK = 128
GMLP_HEADS = 4
D_GMLP = GMLP_HEADS * HEAD_DIM
CHUNK = 128
D_MIX = D_POOL + D_ATTN + D_GMLP
D_IN = D_POOL + 3 * D_ATTN + N_IDX_HEADS * D_IDX + D_IDX + N_IDX_HEADS + 2 * D_GMLP
D_FF = 5632
CONV_W = 3
EPS = 1e-6

kernel_name = "hymba_style_pool_dsa_gmlp_trunk"


def rmsnorm(x, g):
    xf = x.astype(jnp.float32)
    y = xf * lax.rsqrt(jnp.mean(xf * xf, axis=-1, keepdims=True) + EPS)
    return (y * g.astype(jnp.float32)).astype(x.dtype)


def pool_mixer(a, w_pool, scale):
    B, S, _ = a.shape
    a4 = a.reshape(B, S, POOL_GROUPS, HEAD_DIM)
    csum = jnp.cumsum(a4.astype(jnp.float32), axis=1)
    pos = jnp.arange(1, S + 1, dtype=jnp.float32)
    means = []
    for g, w in enumerate(POOL_WINDOWS):
        cg = csum[:, :, g]
        prev = jnp.pad(cg, ((0, 0), (w, 0), (0, 0)))[:, :S]
        means.append((cg - prev) / jnp.minimum(pos, w)[None, :, None])
    pooled = jnp.stack(means, axis=2).astype(a.dtype) - a4
    y = jnp.einsum('bsgc,gcd->bsgd', pooled, w_pool)
    return y.reshape(B, S, D_POOL) * scale


def dsa_mixer(q, k, v, q_idx, k_idx, w_idx):
    B, S, _ = q.shape
    top_k = min(TOPK_MAX, S // 4)
    q = q.reshape(B, S, N_ATTN_HEADS, HEAD_DIM)
    k = k.reshape(B, S, N_ATTN_HEADS, HEAD_DIM)
    v = v.reshape(B, S, N_ATTN_HEADS, HEAD_DIM)
    q_idx = q_idx.reshape(B, S, N_IDX_HEADS, D_IDX)
    k_idx_f = k_idx.astype(jnp.float32)
    nb = S // Q_BLOCK

    def to_blocks(t):
        return jnp.moveaxis(t.reshape(B, nb, Q_BLOCK, *t.shape[2:]), 1, 0)

    starts = jnp.arange(nb, dtype=jnp.int32) * Q_BLOCK
    key_pos = jnp.arange(S, dtype=jnp.int32)

    def one_block(args):
        qb, qib, wb, start = args
        qpos = start + jnp.arange(Q_BLOCK, dtype=jnp.int32)
        causal = key_pos[None, :] <= qpos[:, None]
        logits = jnp.einsum('bthd,bsd->bths', qib.astype(jnp.float32), k_idx_f) * (D_IDX ** -0.5)
        wts = wb.astype(jnp.float32) * (N_IDX_HEADS ** -0.5)
        score = jnp.einsum('bth,bths->bts', wts, jax.nn.relu(logits))
        score = jnp.where(causal[None], score, -jnp.inf)
        _, idx = lax.top_k(score, top_k)
        valid = idx <= qpos[None, :, None]
        k_sel = jax.vmap(lambda kb, ib: kb[ib])(k, idx)
        v_sel = jax.vmap(lambda vb, ib: vb[ib])(v, idx)
        s = jnp.einsum('bthd,btkhd->bthk', qb, k_sel).astype(jnp.float32) * (HEAD_DIM ** -0.5)
        s = jnp.where(valid[:, :, None, :], s, -jnp.inf)
        p = jax.nn.softmax(s, axis=-1).astype(v.dtype)
        return jnp.einsum('bthk,btkhd->bthd', p, v_sel)

    out = lax.map(one_block, (to_blocks(q), to_blocks(q_idx), to_blocks(w_idx), starts))
    return jnp.moveaxis(out, 0, 1).reshape(B, S, D_ATTN)


def gmlp_mixer(z, ln_g, ln_b, w_s, b_s):
    B, S, _ = z.shape
    z = jax.nn.gelu(z)
    u, v = jnp.split(z, 2, axis=-1)
    vf = v.astype(jnp.float32)
    mu = jnp.mean(vf, axis=-1, keepdims=True)
    var = jnp.mean(jnp.square(vf - mu), axis=-1, keepdims=True)
    v = ((vf - mu) * lax.rsqrt(var + EPS) * ln_g.astype(jnp.float32) + ln_b.astype(jnp.float32)).astype(z.dtype)
    v = v.reshape(B, S // CHUNK, CHUNK, GMLP_HEADS, HEAD_DIM)
    mask = jnp.tril(jnp.ones((CHUNK, CHUNK), dtype=bool))
    ws = jnp.where(mask[None], w_s, 0.0)
    mixed = jnp.einsum('gts,bnsgc->bntgc', ws, v) + b_s.T[None, None, :, :, None]
    return u * mixed.reshape(B, S, D_GMLP)


def conv_ffn(h, w_up, conv_w, conv_b, w_down):
    S = h.shape[1]
    up = h @ w_up
    upp = jnp.pad(up, ((0, 0), (CONV_W - 1, 0), (0, 0)))
    conv = conv_b + conv_w[0] * upp[:, 0:S]
    for j in range(1, CONV_W):
        conv = conv + conv_w[j] * upp[:, j:j + S]
    gate, val = jnp.split(conv, 2, axis=-1)
    return (jax.nn.silu(gate) * val) @ w_down


def setup_inputs(seed: int = 0) -> dict:
    key = jax.random.key(seed)
    ks = jax.random.split(key, 18)
    f32 = jnp.float32
    nrm = lambda k, shape, s: jax.random.normal(k, shape, f32) * s
    return {
        "x": nrm(ks[0], (BATCH, SEQ, D_MODEL), 1.0),
        "w_in": nrm(ks[1], (DEPTH, D_MODEL, D_IN), D_MODEL ** -0.5),
        "pool_w": nrm(ks[2], (DEPTH, POOL_GROUPS, HEAD_DIM, HEAD_DIM), HEAD_DIM ** -0.5),
        "pool_scale": 1.0 + nrm(ks[3], (DEPTH, D_POOL), 0.02),
        "sgu_ln_g": 1.0 + nrm(ks[4], (DEPTH, D_GMLP), 0.02),
        "sgu_ln_b": nrm(ks[5], (DEPTH, D_GMLP), 0.02),
        "sgu_w": nrm(ks[6], (DEPTH, GMLP_HEADS, CHUNK, CHUNK), 0.5 * CHUNK ** -0.5),
        "sgu_b": 1.0 + nrm(ks[7], (DEPTH, GMLP_HEADS, CHUNK), 0.02),
        "w_out": nrm(ks[8], (DEPTH, D_MIX, D_MODEL), D_MIX ** -0.5),
        "ffn_w_up": nrm(ks[9], (DEPTH, D_MODEL, 2 * D_FF), D_MODEL ** -0.5),
        "ffn_conv_w": nrm(ks[10], (DEPTH, CONV_W, 2 * D_FF), CONV_W ** -0.5),
        "ffn_conv_b": nrm(ks[11], (DEPTH, 2 * D_FF), 0.01),
        "ffn_w_down": nrm(ks[12], (DEPTH, D_FF, D_MODEL), D_FF ** -0.5),
        "norm_pre_mix": 1.0 + nrm(ks[13], (DEPTH, D_MODEL), 0.02),
        "norm_post_mix": 1.0 + nrm(ks[14], (DEPTH, D_MODEL), 0.02),
        "norm_pre_ffn": 1.0 + nrm(ks[15], (DEPTH, D_MODEL), 0.02),
        "norm_post_ffn": 1.0 + nrm(ks[16], (DEPTH, D_MODEL), 0.02),
    }


def reference(x, w_in, pool_w, pool_scale, sgu_ln_g, sgu_ln_b, sgu_w, sgu_b, w_out,
              ffn_w_up, ffn_conv_w, ffn_conv_b, ffn_w_down,
              norm_pre_mix, norm_post_mix, norm_pre_ffn, norm_post_ffn):
    sizes = (D_POOL, D_ATTN, D_ATTN, D_ATTN, N_IDX_HEADS * D_IDX, D_IDX, N_IDX_HEADS, 2 * D_GMLP)
    points = []
    acc = 0
    for s in sizes[:-1]:
        acc += s
        points.append(acc)
    for l in range(DEPTH):
        h = rmsnorm(x, norm_pre_mix[l])
        z = h @ w_in[l]
        z_pool, q, k, v, q_idx, k_idx, w_idx, z_gmlp = jnp.split(z, points, axis=-1)
        y_pool = pool_mixer(z_pool, pool_w[l], pool_scale[l])
        y_attn = dsa_mixer(q, k, v, q_idx, k_idx, w_idx)
        y_gmlp = gmlp_mixer(z_gmlp, sgu_ln_g[l], sgu_ln_b[l], sgu_w[l], sgu_b[l])
        mix = jnp.concatenate([y_pool, y_attn, y_gmlp], axis=-1) @ w_out[l]
        x = x + rmsnorm(mix, norm_post_mix[l])
        h = rmsnorm(x, norm_pre_ffn[l])
        f = conv_ffn(h, ffn_w_up[l], ffn_conv_w[l], ffn_conv_b[l], ffn_w_down[l])
        x = x + rmsnorm(f, norm_post_ffn[l])
    return x
```

```cpp
#include <hip/hip_runtime.h>
#include <cstdio>
#include <cstdint>

#ifndef MK_MULTI
#define MK_MULTI 0
#endif
namespace pg8 {
#define PG8_LAS __attribute__((address_space(3)))
typedef unsigned short bf16_t;
typedef short bf16x8 __attribute__((ext_vector_type(8)));
typedef float f32x4 __attribute__((ext_vector_type(4)));
typedef unsigned u32x4 __attribute__((ext_vector_type(4)));
constexpr int BM = 256, BK = 64, HALF = 128, HTB = HALF * BK * 2  , STAGE_BYTES = 8 * HTB, NXCD = 8, WGM = 8;

__host__ __device__ __forceinline__ int lds_byte(int r, int c) { const int st = (r >> 4) * 2 + (c >> 5), rr = r & 15, cc = c & 31, ob = rr * 64 + cc * 2; return st * 1024 + (ob ^ (((ob >> 9) & 1) << 5)); }
__host__ __device__ __forceinline__ void stage_rc(int b, int& R, int& C) { const int st = b / 1024, sb = b % 1024, swz = sb ^ (((sb >> 9) & 1) << 5); R = (st >> 1) * 16 + swz / 64; C = (st & 1) * 32 + (swz % 64) / 2; }
__host__ __device__ __forceinline__ int perm32(int rho) { const int n = rho >> 4, i = rho & 15; return 8 * (i >> 2) + 4 * n + (i & 3); }

struct Unit { int pm, pn; };
struct Gemm { const bf16_t* A; const bf16_t* Bt; int M, N, K; };

struct StaticOrder {
    int nM, nN, nwg, G, c;
    __host__ __device__ void init(int M, int N, int G_, int c_) { nM = M / BM; nN = N / BM; nwg = nM * nN; G = G_; c = c_; }
    __host__ __device__ bool next(int i, Unit& u) const {
        const long L = (long)i * G + c; if (L >= nwg) return false;
        int wgid = (int)L; { const int q = nwg / NXCD, r = nwg % NXCD, xcd = wgid % NXCD, off = wgid / NXCD; wgid = (xcd < r ? xcd * (q + 1) : r * (q + 1) + (xcd - r) * q) + off; }
        const int nig = WGM * nN, gid = wgid / nig, fm = gid * WGM, gsz = (nM - fm) < WGM ? (nM - fm) : WGM;
        u.pm = fm + ((wgid % nig) % gsz); u.pn = (wgid % nig) / gsz; return true;
    }
    __device__ __forceinline__ void a_ready(const Unit&) const {}
    __device__ __forceinline__ void done(const Unit&) const {}
};

__device__ __forceinline__ unsigned cvt_pk_bf16(float lo, float hi) { unsigned r; asm volatile("v_cvt_pk_bf16_f32 %0, %1, %2" : "=v"(r) : "v"(lo), "v"(hi)); return r; }
__device__ __forceinline__ float gelu_tanh(float x) {
    const float u = x * (1.0f + 0.044715f * x * x);
    const float e = __builtin_amdgcn_exp2f(u * (-2.0f * 0.7978845608028654f * 1.4426950408889634f));
    return x * __builtin_amdgcn_rcpf(1.0f + e);
}
struct EpiRowScaleBf16 {
    static constexpr bool PERM = true, AFTER_DRAIN = false;
    bf16_t* O; int ldc; const float* rs; int gelu_pn0;
    __device__ __forceinline__ void operator()(const f32x4 (&acc)[2][2][4][2], const Unit& u, int wr, int wc, int fr, int fq) const {
        const int row0 = u.pm * BM + wr * 64 + fr, col0 = u.pn * BM + wc * 32 + 8 * fq;
        const bool g = u.pn >= gelu_pn0;
#pragma unroll
        for (int ai = 0; ai < 2; ++ai)
#pragma unroll
            for (int m = 0; m < 4; ++m) { const int row = row0 + ai * HALF + m * 16; const float s = rs[row]; bf16_t* rowp = O + (size_t)row * ldc + col0;
#pragma unroll
                for (int bj = 0; bj < 2; ++bj) { f32x4 v0 = acc[ai][bj][m][0] * s, v1 = acc[ai][bj][m][1] * s;
                    if (g) {
#pragma unroll
                        for (int j = 0; j < 4; ++j) { v0[j] = gelu_tanh(v0[j]); v1[j] = gelu_tanh(v1[j]); } }
                    u32x4 w; w.x = cvt_pk_bf16(v0[0], v0[1]); w.y = cvt_pk_bf16(v0[2], v0[3]); w.z = cvt_pk_bf16(v1[0], v1[1]); w.w = cvt_pk_bf16(v1[2], v1[3]);
                    *(u32x4*)(rowp + bj * HALF) = w; } }
    }
};
struct EpiF32 {
    static constexpr bool PERM = false, AFTER_DRAIN = false;
    float* C; int ldc;
    __device__ __forceinline__ void operator()(const f32x4 (&acc)[2][2][4][2], const Unit& u, int wr, int wc, int fr, int fq) const {
        const int row0 = u.pm * BM + wr * 64 + fr, col0 = u.pn * BM + wc * 32 + 4 * fq;
#pragma unroll
        for (int ai = 0; ai < 2; ++ai)
#pragma unroll
            for (int m = 0; m < 4; ++m) { float* rowp = C + (size_t)(row0 + ai * HALF + m * 16) * ldc + col0;
#pragma unroll
                for (int bj = 0; bj < 2; ++bj)
#pragma unroll
                    for (int n = 0; n < 2; ++n) *(f32x4*)(rowp + bj * HALF + n * 16) = acc[ai][bj][m][n]; }
    }
};

template <class Epi, class Sched, bool ALIGN_EPI = false, bool SP2 = false>
__device__ __forceinline__ void gemm_phase(PG8_LAS unsigned char* lds, const Gemm g, const Sched& S, const Epi& E) {
    int tid_ = threadIdx.x; asm volatile("" : "+v"(tid_)); const int tid = tid_, wid = __builtin_amdgcn_readfirstlane(tid >> 6), lane = tid & 63, wr = wid >> 2, wc = wid & 3, fr = lane & 15, fq = lane >> 4;
    const int K = g.K, nt = K / BK;
    unsigned voffA[2], voffB[2];
#pragma unroll
    for (int i = 0; i < 2; ++i) { int R, C; stage_rc(tid * 16 + i * 8192, R, C); const int Rb = Epi::PERM ? ((R & ~31) + perm32(R & 31)) : R;
        voffA[i] = (unsigned)(R * K + C) * 2u; voffB[i] = (unsigned)(Rb * K + C) * 2u; }
    const size_t kstep = (size_t)(BK * 2);
    const size_t hstep = (size_t)HALF * K * 2;
    const size_t tstep = 2 * hstep;
    const unsigned ldsw = (unsigned)wid * 1024u;
    const int aoff = lds_byte(wr * 64 + fr, fq * 8), boff = lds_byte(wc * 32 + fr, fq * 8);
#define PG8_SA(b, h) (((b) * 2 + (h)) * HTB)
#define PG8_SB(b, h) ((4 + (b) * 2 + (h)) * HTB)
#define PG8_STAGE(bufoff, gbase, voff) do { _Pragma("unroll") for (int _i = 0; _i < 2; ++_i) \
        __builtin_amdgcn_global_load_lds((const unsigned*)((const char*)(gbase) + (voff)[_i]), (PG8_LAS unsigned*)(lds + (bufoff) + ldsw + _i * 8192), 16, 0, 0); } while (0)
#define PG8_LDA(dst, b, h) do { _Pragma("unroll") for (int m = 0; m < 4; ++m) _Pragma("unroll") for (int k = 0; k < 2; ++k) dst[m][k] = *(const PG8_LAS bf16x8*)(lds + PG8_SA(b, h) + aoff + m * 2048 + k * 1024); } while (0)
#define PG8_LDB(dst, b, h) do { _Pragma("unroll") for (int n = 0; n < 2; ++n) _Pragma("unroll") for (int k = 0; k < 2; ++k) dst[n][k] = *(const PG8_LAS bf16x8*)(lds + PG8_SB(b, h) + boff + n * 2048 + k * 1024); } while (0)
#define PG8_MMA(ai, bj, At, Bt) do { __builtin_amdgcn_s_setprio(1); _Pragma("unroll") for (int m = 0; m < 4; ++m) _Pragma("unroll") for (int n = 0; n < 2; ++n) _Pragma("unroll") for (int k = 0; k < 2; ++k) \
        acc[ai][bj][m][n] = __builtin_amdgcn_mfma_f32_16x16x32_bf16(Bt[n][k], At[m][k], acc[ai][bj][m][n], 0, 0, 0); __builtin_amdgcn_s_setprio(0); } while (0)
#define PG8_WAIT_V(n) asm volatile("s_waitcnt vmcnt(" #n ")" ::: "memory")
#define PG8_WAIT_L(n) asm volatile("s_waitcnt lgkmcnt(" #n ")" ::: "memory")
#define PG8_BAR __builtin_amdgcn_s_barrier()
#define PG8_SCHED __builtin_amdgcn_sched_barrier(0)
    Unit cur, nxt; int ui = 0;
    if (!S.next(0, cur)) return;
    f32x4 acc[2][2][4][2];
#pragma unroll
    for (int a = 0; a < 2; ++a)
#pragma unroll
        for (int b = 0; b < 2; ++b)
#pragma unroll
            for (int m = 0; m < 4; ++m)
#pragma unroll
                for (int n = 0; n < 2; ++n) acc[a][b][m][n] = (f32x4){0.f, 0.f, 0.f, 0.f};
    bf16x8 At[4][2], B0[2][2], B1[2][2];
    const char* cA = (const char*)g.A + (size_t)cur.pm * tstep; const char* cB = (const char*)g.Bt + (size_t)cur.pn * tstep;
    S.a_ready(cur);
    if constexpr (SP2) {
        PG8_STAGE(PG8_SB(0, 0), cB, voffB); PG8_STAGE(PG8_SB(0, 1), cB + hstep, voffB); PG8_STAGE(PG8_SA(0, 0), cA, voffA); PG8_STAGE(PG8_SA(0, 1), cA + hstep, voffA);
        if (wr == 1) PG8_BAR;
        PG8_WAIT_V(2); PG8_BAR;
        PG8_STAGE(PG8_SB(1, 0), cB + kstep, voffB); PG8_STAGE(PG8_SA(1, 0), cA + kstep, voffA); PG8_STAGE(PG8_SB(1, 1), cB + hstep + kstep, voffB);
        PG8_WAIT_V(6); PG8_BAR;
    } else {
        PG8_STAGE(PG8_SB(0, 0), cB, voffB); PG8_STAGE(PG8_SA(0, 0), cA, voffA); PG8_STAGE(PG8_SB(0, 1), cB + hstep, voffB); PG8_STAGE(PG8_SA(0, 1), cA + hstep, voffA);
        if (wr == 1) PG8_BAR;
        PG8_WAIT_V(4); PG8_BAR;
        PG8_STAGE(PG8_SB(1, 0), cB + kstep, voffB); PG8_STAGE(PG8_SA(1, 0), cA + kstep, voffA); PG8_STAGE(PG8_SB(1, 1), cB + hstep + kstep, voffB);
        PG8_WAIT_V(6); PG8_BAR;
    }
    for (;;) {
        const bool has_next = S.next(ui + 1, nxt);
        const char* nA = has_next ? (const char*)g.A + (size_t)nxt.pm * tstep : cA; const char* nB = has_next ? (const char*)g.Bt + (size_t)nxt.pn * tstep : cB;
        for (int t = 0; t < nt; t += 2) {
            const bool last = (t == nt - 2);
            const char* a1 = cA + (size_t)(t + 1) * kstep;
            const char* a2 = last ? nA : cA + (size_t)(t + 2) * kstep; const char* b2 = last ? nB : cB + (size_t)(t + 2) * kstep;
            const char* a3 = a2 + kstep; const char* b3 = b2 + kstep;
            if (last && has_next) S.a_ready(nxt);
            if constexpr (SP2) {
            PG8_LDB(B0, 0, 0); PG8_LDB(B1, 0, 1); PG8_SCHED; PG8_LDA(At, 0, 0); PG8_STAGE(PG8_SA(1, 1), a1 + hstep, voffA);
            PG8_WAIT_V(8); PG8_WAIT_L(0); PG8_BAR; PG8_MMA(0, 0, At, B0); PG8_MMA(0, 1, At, B1); PG8_BAR; PG8_SCHED;
            PG8_LDA(At, 0, 1); PG8_STAGE(PG8_SB(0, 0), b2, voffB); PG8_STAGE(PG8_SB(0, 1), b2 + hstep, voffB); PG8_STAGE(PG8_SA(0, 0), a2, voffA);
            PG8_WAIT_V(8); PG8_WAIT_L(0); PG8_BAR; PG8_MMA(1, 0, At, B0); PG8_MMA(1, 1, At, B1); PG8_BAR; PG8_SCHED;
            PG8_LDB(B0, 1, 0); PG8_LDB(B1, 1, 1); PG8_SCHED; PG8_LDA(At, 1, 0); PG8_STAGE(PG8_SA(0, 1), a2 + hstep, voffA);
            PG8_WAIT_V(8); PG8_WAIT_L(0); PG8_BAR; PG8_MMA(0, 0, At, B0); PG8_MMA(0, 1, At, B1); PG8_BAR; PG8_SCHED;
            PG8_LDA(At, 1, 1); PG8_STAGE(PG8_SB(1, 0), b3, voffB); PG8_STAGE(PG8_SB(1, 1), b3 + hstep, voffB); PG8_STAGE(PG8_SA(1, 0), a3, voffA);
            PG8_WAIT_V(8); PG8_WAIT_L(0); PG8_BAR; PG8_MMA(1, 0, At, B0); PG8_MMA(1, 1, At, B1); PG8_BAR; PG8_SCHED;
            } else {
            PG8_LDB(B0, 0, 0); PG8_SCHED; PG8_LDA(At, 0, 0); PG8_STAGE(PG8_SA(1, 1), a1 + hstep, voffA);
            PG8_WAIT_L(8); PG8_BAR; PG8_WAIT_L(0); PG8_MMA(0, 0, At, B0); PG8_BAR; PG8_SCHED;
            PG8_LDB(B1, 0, 1); PG8_STAGE(PG8_SB(0, 0), b2, voffB);
            PG8_BAR; PG8_WAIT_L(0); PG8_MMA(0, 1, At, B1); PG8_BAR;
            PG8_LDA(At, 0, 1); PG8_STAGE(PG8_SA(0, 0), a2, voffA);
            PG8_BAR; PG8_WAIT_L(0); PG8_MMA(1, 0, At, B0); PG8_BAR; PG8_SCHED;
            PG8_STAGE(PG8_SB(0, 1), b2 + hstep, voffB);
            PG8_WAIT_V(6); PG8_BAR; PG8_MMA(1, 1, At, B1); PG8_BAR;
            PG8_LDB(B0, 1, 0); PG8_SCHED; PG8_LDA(At, 1, 0); PG8_STAGE(PG8_SA(0, 1), a2 + hstep, voffA);
            PG8_WAIT_L(8); PG8_BAR; PG8_WAIT_L(0); PG8_MMA(0, 0, At, B0); PG8_BAR; PG8_SCHED;
            PG8_LDB(B1, 1, 1); PG8_STAGE(PG8_SB(1, 0), b3, voffB);
            PG8_BAR; PG8_WAIT_L(0); PG8_MMA(0, 1, At, B1); PG8_BAR;
            PG8_LDA(At, 1, 1); PG8_STAGE(PG8_SA(1, 0), a3, voffA);
            PG8_BAR; PG8_WAIT_L(0); PG8_MMA(1, 0, At, B0); PG8_BAR; PG8_SCHED;
            PG8_STAGE(PG8_SB(1, 1), b3 + hstep, voffB);
            PG8_WAIT_V(6); PG8_BAR; PG8_MMA(1, 1, At, B1); PG8_BAR;
            }
        }
        if constexpr (ALIGN_EPI) { if (wr == 0) PG8_BAR; }
        if constexpr (!Epi::AFTER_DRAIN) { E(acc, cur, wr, wc, fr, fq); S.done(cur); }
        if (!has_next) break;
#pragma unroll
        for (int a = 0; a < 2; ++a)
#pragma unroll
            for (int b = 0; b < 2; ++b)
#pragma unroll
                for (int m = 0; m < 4; ++m)
#pragma unroll
                    for (int n = 0; n < 2; ++n) acc[a][b][m][n] = (f32x4){0.f, 0.f, 0.f, 0.f};
        cur = nxt; cA = nA; cB = nB; ++ui;
        if constexpr (ALIGN_EPI) { if (wr == 1) PG8_BAR; }
    }
    PG8_WAIT_V(0);
    if constexpr (!ALIGN_EPI) { if (wr == 0) PG8_BAR; }
    PG8_BAR;
    if constexpr (Epi::AFTER_DRAIN) { E.fused(acc, cur, wr, wc, fr, fq, lds, wid, lane); S.done(cur); }
#undef PG8_SA
#undef PG8_SB
#undef PG8_STAGE
#undef PG8_LDA
#undef PG8_LDB
#undef PG8_MMA
#undef PG8_WAIT_V
#undef PG8_WAIT_L
#undef PG8_BAR
#undef PG8_SCHED
}
}

namespace att {
typedef unsigned short bf16;
typedef short bf16x8 __attribute__((ext_vector_type(8)));
typedef short s16x4 __attribute__((ext_vector_type(4)));
typedef float f32x16 __attribute__((ext_vector_type(16)));
typedef float f32x4 __attribute__((ext_vector_type(4)));
typedef unsigned u32x4 __attribute__((ext_vector_type(4)));
constexpr int D = 128, NW = 8, QBLK = 32, KVBLK = 64, QB = NW * QBLK;
constexpr int SHM_V = KVBLK * D * 2, SHM_K = KVBLK * D * 2;
constexpr int LDS_BYTES = 2 * SHM_V + 2 * SHM_K + NW * 64 * 4;
constexpr float SCALE = 0.08838834764831845f;
constexpr float THR = 8.f;
constexpr int PQ = 5888;
constexpr int PO = 2048;
constexpr int MSTRIDE = 4096;

#define KSWZ(row, colB) ((row) * 256 + ((colB) ^ (((row) & 7) << 4)))
#define SBAR() __builtin_amdgcn_sched_barrier(0)
__device__ __forceinline__ int v_st(int k, int c) { const int kk = (k & ~0xC) | ((k & 4) << 1) | ((k & 8) >> 1); return ((kk >> 3) * 4 + (c >> 5)) * 512 + ((kk & 7) * 32 + (c & 31)) * 2; }
__device__ __forceinline__ int v_rd_base(int lane) { return ((lane & 3) << 3) | (((lane >> 2) & 3) << 6) | (((lane >> 4) & 1) << 5) | (((lane >> 5) & 1) << 8); }
constexpr int v_rd_off(int d0, int ks, int half) { return d0 * 512 + ks * 4096 + half * 2048; }
__device__ __forceinline__ int crow(int r, int hi) { return (r & 3) + 8 * (r >> 2) + 4 * hi; }
__device__ __forceinline__ unsigned cvtpk(float lo, float hi) { unsigned r; asm volatile("v_cvt_pk_bf16_f32 %0, %1, %2" : "=v"(r) : "v"(lo), "v"(hi)); return r; }
#define LOAD8(rs, voff, soff) __builtin_bit_cast(bf16x8, __builtin_amdgcn_raw_buffer_load_b128((rs), (int)(voff), (int)(soff), 0))
__device__ __forceinline__ void mask_bits(f32x16& p0, f32x16& p1, unsigned long long mw, int hi) {
    const float NEG = -__builtin_inff();
    const unsigned w0 = ((unsigned)mw) >> (4 * hi), w1 = ((unsigned)(mw >> 32)) >> (4 * hi);
#pragma unroll
    for (int r = 0; r < 16; ++r) {
        const int c = (r & 3) + 8 * (r >> 2);
        if (!((w0 >> c) & 1u)) p0[r] = NEG;
        if (!((w1 >> c) & 1u)) p1[r] = NEG;
    }
}
__device__ __forceinline__ void partialSM(f32x16& p0, f32x16& p1, float& m_reg, float& mn, float& alpha) {
    float pmax = p0[0];
#pragma unroll
    for (int r = 1; r < 16; ++r) pmax = fmaxf(pmax, p0[r]);
#pragma unroll
    for (int r = 0; r < 16; ++r) pmax = fmaxf(pmax, p1[r]);
    { auto rr = __builtin_amdgcn_permlane32_swap(__float_as_uint(pmax), __float_as_uint(pmax), false, false);
      pmax = fmaxf(__uint_as_float(rr[0]), __uint_as_float(rr[1])); }
    constexpr float C2 = 1.4426950408889634f * SCALE;
    if (__builtin_expect(__all((pmax - m_reg) * SCALE <= THR), 1)) { mn = m_reg; alpha = 1.f; }
    else { mn = fmaxf(m_reg, pmax); alpha = __builtin_amdgcn_exp2f((m_reg - mn) * C2); m_reg = mn; }
    const float mnL = -mn * C2;
#pragma unroll
    for (int r = 0; r < 16; ++r) p0[r] = fmaf(p0[r], C2, mnL);
#pragma unroll
    for (int r = 0; r < 16; ++r) p1[r] = fmaf(p1[r], C2, mnL);
#pragma unroll
    for (int r = 0; r < 16; ++r) p0[r] = __builtin_amdgcn_exp2f(p0[r]);
}
__device__ __forceinline__ void finishSM(f32x16& p0, f32x16& p1, float alpha, float& l_reg, bf16x8& pa0, bf16x8& pa1, bf16x8& pa2, bf16x8& pa3) {
#pragma unroll
    for (int r = 0; r < 16; ++r) p1[r] = __builtin_amdgcn_exp2f(p1[r]);
    float ps = 0;
#pragma unroll
    for (int r = 0; r < 16; ++r) ps += p0[r];
#pragma unroll
    for (int r = 0; r < 16; ++r) ps += p1[r];
    { auto rr = __builtin_amdgcn_permlane32_swap(__float_as_uint(ps), __float_as_uint(ps), false, false);
      ps = __uint_as_float(rr[0]) + __uint_as_float(rr[1]); }
    l_reg = l_reg * alpha + ps;
#define PK4(P, B_, OUT) do { unsigned a0 = cvtpk(P[B_+0], P[B_+1]), a1 = cvtpk(P[B_+2], P[B_+3]);                          \
        unsigned b0 = cvtpk(P[B_+4], P[B_+5]), b1 = cvtpk(P[B_+6], P[B_+7]);                                             \
        auto r0 = __builtin_amdgcn_permlane32_swap(a0, b0, false, false); auto r1 = __builtin_amdgcn_permlane32_swap(a1, b1, false, false); \
        u32x4 w = {r0[0], r1[0], r0[1], r1[1]}; OUT = *reinterpret_cast<bf16x8*>(&w); } while (0)
    PK4(p0, 0, pa0); PK4(p0, 8, pa1); PK4(p1, 0, pa2); PK4(p1, 8, pa3);
#undef PK4
}
template <int KB>
__device__ __forceinline__ void qkt(f32x16& p0, f32x16& p1, const char* K_lds, int r32, int hi, const bf16x8* qr) {
    p0 = f32x16{}; p1 = f32x16{};
    const char* kb[4];
#pragma unroll
    for (int dd = 0; dd < 4; ++dd) kb[dd] = K_lds + KB * SHM_K + KSWZ(r32, (dd * 16 + hi * 8) * 2);
#pragma unroll
    for (int d0 = 0; d0 < 8; ++d0) { const char* a = kb[d0 & 3] + (d0 >> 2) * 128;
        bf16x8 b0 = *reinterpret_cast<const bf16x8*>(a);
        bf16x8 b1 = *reinterpret_cast<const bf16x8*>(a + 32 * 256);
        p0 = __builtin_amdgcn_mfma_f32_32x32x16_bf16(b0, qr[d0], p0, 0, 0, 0);
        p1 = __builtin_amdgcn_mfma_f32_32x32x16_bf16(b1, qr[d0], p1, 0, 0, 0); }
}
template <int VB>
__device__ __forceinline__ void pv_tile(f32x16* o, int vb0, bf16x8 pa0, bf16x8 pa1, bf16x8 pa2, bf16x8 pa3) {
#define TRRD(dst, off) asm volatile("ds_read_b64_tr_b16 %0, %1 offset:%2" : "=&v"(dst) : "v"(vb0), "i"(off) : "memory")
#define PV_D0(d0) do { s16x4 l0, l1, l2, l3, h0, h1, h2, h3; constexpr int b_ = VB * SHM_V + v_rd_off(d0, 0, 0);   \
        TRRD(l0, b_); TRRD(h0, b_ + 2048); TRRD(l1, b_ + 4096); TRRD(h1, b_ + 6144); TRRD(l2, b_ + 8192); TRRD(h2, b_ + 10240); TRRD(l3, b_ + 12288); TRRD(h3, b_ + 14336); \
        asm volatile("s_waitcnt lgkmcnt(0)" ::: "memory"); SBAR();   \
        o[d0] = __builtin_amdgcn_mfma_f32_32x32x16_bf16(pa0, (bf16x8){l0[0], l0[1], l0[2], l0[3], h0[0], h0[1], h0[2], h0[3]}, o[d0], 0, 0, 0);   \
        o[d0] = __builtin_amdgcn_mfma_f32_32x32x16_bf16(pa1, (bf16x8){l1[0], l1[1], l1[2], l1[3], h1[0], h1[1], h1[2], h1[3]}, o[d0], 0, 0, 0);   \
        o[d0] = __builtin_amdgcn_mfma_f32_32x32x16_bf16(pa2, (bf16x8){l2[0], l2[1], l2[2], l2[3], h2[0], h2[1], h2[2], h2[3]}, o[d0], 0, 0, 0);   \
        o[d0] = __builtin_amdgcn_mfma_f32_32x32x16_bf16(pa3, (bf16x8){l3[0], l3[1], l3[2], l3[3], h3[0], h3[1], h3[2], h3[3]}, o[d0], 0, 0, 0); } while (0)
    PV_D0(0); PV_D0(1); PV_D0(2); PV_D0(3);
#undef PV_D0
#undef TRRD
}

struct BlockRef { unsigned qo, ko, vo, oo, mo; int P0; };
struct Res { __amdgpu_buffer_rsrc_t z, mix, mk; };
typedef unsigned ru4 __attribute__((__vector_size__(16)));
typedef unsigned ru2 __attribute__((__vector_size__(8)));
struct Seam { bf16x8 qr[8]; bf16x8 st_v0, st_v1, st_k0, st_k1; };
#define VMW() asm volatile("s_waitcnt vmcnt(0)" ::: "memory")
#define VMWN(n) asm volatile("s_waitcnt vmcnt(%0)" :: "i"(n) : "memory")
#define SLOAD_H(Kp, Vp, k0) do { const unsigned vp_ = (Vp) + (unsigned)(k0) * (PQ * 2), kp_ = (Kp) + (unsigned)(k0) * (PQ * 2);                  \
                         S.st_v0 = LOAD8(R.z, kvoff, vp_); S.st_v1 = LOAD8(R.z, kvoff, vp_ + 32 * PQ * 2);              \
                         S.st_k0 = LOAD8(R.z, kvoff, kp_); S.st_k1 = LOAD8(R.z, kvoff, kp_ + 32 * PQ * 2); } while (0)
#define SWRITE_HK(bf) do { *(bf16x8*)(K_lds + (bf) * SHM_K + kws) = S.st_k0; *(bf16x8*)(K_lds + (bf) * SHM_K + kws + 32 * 256) = S.st_k1; } while (0)
#define SWRITE_HV(bf) do { *(bf16x8*)(V_lds + (bf) * SHM_V + vst0) = S.st_v0; *(bf16x8*)(V_lds + (bf) * SHM_V + vst1) = S.st_v1; } while (0)
#define SWRITE_H(bf) do { SWRITE_HV(bf); SWRITE_HK(bf); } while (0)
__device__ __forceinline__ void prime(const Res& R, const BlockRef& cur, char* lds, Seam& S) {
    int tid_ = threadIdx.x; asm volatile("" : "+v"(tid_)); const int tid = tid_, wid = __builtin_amdgcn_readfirstlane(tid >> 6), lane = tid & 63, r32 = lane & 31, hi = lane >> 5;
    const int sr = tid >> 4, sc = (tid & 15) * 8, kws = KSWZ(sr, sc * 2); char* K_lds = lds + 2 * SHM_V;
    const unsigned kvoff = (unsigned)(sr * PQ + sc) * 2u, qoff = (unsigned)(r32 * PQ + hi * 8) * 2u;
    { const unsigned qb_ = cur.qo + (unsigned)(wid * QBLK) * (PQ * 2);
#pragma unroll
    for (int d0 = 0; d0 < 8; ++d0) S.qr[d0] = LOAD8(R.z, qoff, qb_ + d0 * 32); }
    SLOAD_H(cur.ko, cur.vo, 0); VMW(); SWRITE_HK(0);
    __syncthreads();
}
__device__ __forceinline__ void block(const Res& R, const BlockRef& cur, const BlockRef& nxt, char* lds, Seam& S) {
    int tid_ = threadIdx.x; asm volatile("" : "+v"(tid_)); const int tid = tid_, wid = __builtin_amdgcn_readfirstlane(tid >> 6), lane = tid & 63, r32 = lane & 31, hi = lane >> 5;
    const int NT = cur.P0 / KVBLK + QB / KVBLK;
    char* V_lds = lds; char* K_lds = lds + 2 * SHM_V;
    float* ws = (float*)(lds + 2 * SHM_V + 2 * SHM_K) + wid * 64; float* li_l = ws, * al_l = ws + 32;
    float m_reg = -1e30f, l_reg = 0; f32x16 o[4] = {};
    const int sr = tid >> 4, sc = (tid & 15) * 8, vst0 = v_st(sr, sc), vst1 = v_st(32 + sr, sc), kws = KSWZ(sr, sc * 2);
    const int vb0 = (int)(uintptr_t)V_lds + v_rd_base(lane);
    const unsigned Kh = cur.ko, Vh = cur.vo;
    const unsigned kvoff = (unsigned)(sr * PQ + sc) * 2u, qoff = (unsigned)(r32 * PQ + hi * 8) * 2u, mkoff = (unsigned)r32 * 8u;
    const unsigned mk = cur.mo + (unsigned)(wid * QBLK) * 8u;
#define MKW(t) __builtin_bit_cast(unsigned long long, __builtin_amdgcn_raw_buffer_load_b64(R.mk, (int)mkoff, (int)(mk + (unsigned)(t) * (MSTRIDE * 8)), 0))
#define RESC(a) do { if (__any((a) < 1.f)) { if (hi == 0) al_l[r32] = (a); asm volatile("s_waitcnt lgkmcnt(0)" ::: "memory");              \
                     for (int d_ = 0; d_ < 4; ++d_) for (int r = 0; r < 16; ++r) o[d_][r] *= al_l[crow(r, hi)]; } } while (0)
#define KBASE(t) ((t) * KVBLK)
    constexpr int NQL = 8;
#define SEAM_K0() do { VMWN(NQL); SWRITE_HK(0); SBAR(); } while (0)
    f32x16 pA0, pA1, pB0, pB1; float mnA, mnB, alA, alB; bf16x8 pa0, pa1, pa2, pa3;
    SWRITE_HV(0); SBAR();
    if (NT > 1) { SLOAD_H(Kh, Vh, KBASE(1)); }
    const unsigned long long mw0 = MKW(0);
    SBAR(); qkt<0>(pA0, pA1, K_lds, r32, hi, S.qr);
    mask_bits(pA0, pA1, mw0, hi); partialSM(pA0, pA1, m_reg, mnA, alA);
    if (NT > 1) { VMW(); SWRITE_H(1); }
    __syncthreads();
#define HALF_STEP(PX0, PX1, mnX, alX, PY0, PY1, alY, t, KB, VB, SB) do {                                                      \
        const unsigned long long mw_ = MKW(t);                                                             \
        SBAR(); qkt<KB>(PX0, PX1, K_lds, r32, hi, S.qr);                                                                      \
        finishSM(PY0, PY1, alY, l_reg, pa0, pa1, pa2, pa3); SBAR();                                                           \
        if ((t) + 1 < NT) { SLOAD_H(Kh, Vh, KBASE((t) + 1)); SBAR(); }                                                        \
        pv_tile<VB>(o, vb0, pa0, pa1, pa2, pa3); mask_bits(PX0, PX1, mw_, hi); partialSM(PX0, PX1, m_reg, mnX, alX);          \
        __syncthreads();                                                                                                      \
        if ((t) + 1 < NT) { VMW(); SWRITE_H(SB); }                                                                            \
        RESC(alX); __syncthreads(); } while (0)
    for (int t = 1; t + 1 < NT; t += 2) {
        HALF_STEP(pB0, pB1, mnB, alB, pA0, pA1, alA, t, 1, 0, 0);
        HALF_STEP(pA0, pA1, mnA, alA, pB0, pB1, alB, t + 1, 0, 1, 1);
    }
    const bool even = (NT & 1) == 0;
    unsigned long long mwl = 0ull;
    if (even) { mwl = MKW(NT - 1); SBAR(); qkt<1>(pB0, pB1, K_lds, r32, hi, S.qr); SBAR(); }
    SLOAD_H(nxt.ko, nxt.vo, 0); SBAR();
    { const unsigned qb_ = nxt.qo + (unsigned)(wid * QBLK) * (PQ * 2);
#pragma unroll
    for (int d0 = 0; d0 < 8; ++d0) S.qr[d0] = LOAD8(R.z, qoff, qb_ + d0 * 32); }
    SBAR();
    finishSM(pA0, pA1, alA, l_reg, pa0, pa1, pa2, pa3); SBAR();
    pv_tile<0>(o, vb0, pa0, pa1, pa2, pa3);
    if (even) { mask_bits(pB0, pB1, mwl, hi); partialSM(pB0, pB1, m_reg, mnB, alB); __syncthreads(); RESC(alB);
        finishSM(pB0, pB1, alB, l_reg, pa0, pa1, pa2, pa3); SBAR(); pv_tile<1>(o, vb0, pa0, pa1, pa2, pa3); }
    SBAR(); SEAM_K0();
    if (hi == 0) li_l[r32] = l_reg; asm volatile("s_waitcnt lgkmcnt(0)" ::: "memory");
    float rli[16];
#pragma unroll
    for (int r = 0; r < 16; ++r) rli[r] = __builtin_amdgcn_rcpf(li_l[crow(r, hi)]);
    const unsigned Ow = cur.oo + (unsigned)(wid * QBLK) * (PO * 2);
    const unsigned ooff = (unsigned)(4 * hi * PO + r32) * 2u;
#pragma unroll
    for (int r = 0; r < 16; ++r) { const int orow0 = (r & 3) + 8 * (r >> 2);
#pragma unroll
        for (int d0 = 0; d0 < 4; ++d0) { const float v = o[d0][r] * rli[r];
            const float vn = __shfl_xor(v, 1);
            if ((r32 & 1) == 0) __builtin_amdgcn_raw_buffer_store_b32(cvtpk(v, vn), R.mix, (int)ooff, (int)(Ow + (orow0 * PO + d0 * 32) * 2), 0); } }
    __syncthreads();
#undef RESC
#undef MKW
#undef KBASE
#undef SEAM_K0
#undef HALF_STEP
}
#undef ROW
#undef VMW
#undef VMWN
#undef SLOAD_H
#undef SWRITE_HK
#undef SWRITE_HV
#undef SWRITE_H
#undef KSWZ
#undef SBAR
#undef LOAD8
}

constexpr int NWAVES = 8;
constexpr int BATCH = 2, SEQ = 4096, DM = 2048, DEPTH = 4, M = BATCH * SEQ;
constexpr int HD = 128, D_POOL = 512, D_ATTN = 1024, NH = 8, NIH = 16, DIDX = 64, TOPK = 256, D_GMLP = 512, CHUNK = 128;
constexpr int D_IN = 5712, ZP = 5888, D_FF = 5632, D_UP = 2 * D_FF;
constexpr float EPS = 1e-6f;
constexpr int ZC_POOL = 0, ZC_Q = 512, ZC_K = 1536, ZC_V = 2560, ZC_QI = 3584, ZC_KI = 4608, ZC_WI = 4672, ZC_PAD = 4688, ZC_G = 4864;
constexpr int GELU_PN0 = ZC_G / 256;
static_assert(ZC_G % 256 == 0 && ZC_G + 2 * D_GMLP == ZP && ZP % 256 == 0 && att::PQ == ZP && att::PO == DM && att::MSTRIDE == SEQ, "Z layout");

constexpr size_t MiB = 1u << 20;
constexpr size_t SZ_WIN = (size_t)ZP * DM * 2, SZ_WOUT = (size_t)DM * DM * 2, SZ_WUP = (size_t)D_UP * DM * 2, SZ_WDN = (size_t)DM * D_FF * 2;
constexpr size_t WS_CTL = 0, CTL_ZERO_BYTES = 1 * MiB;
constexpr size_t WS_WIN = 1 * MiB;
constexpr size_t WS_WOUT = WS_WIN + DEPTH * SZ_WIN;
constexpr size_t WS_WUP = WS_WOUT + DEPTH * SZ_WOUT;
constexpr size_t WS_WDN = WS_WUP + DEPTH * SZ_WUP;
constexpr size_t WS_XB = WS_WDN + DEPTH * SZ_WDN;
constexpr size_t WS_Z = WS_XB + (size_t)M * DM * 2;
constexpr size_t WS_MIX = WS_Z + (size_t)M * ZP * 2;
constexpr size_t WS_SC = WS_MIX + (size_t)M * DM * 2;
constexpr size_t WS_MASK = WS_SC + (size_t)M * SEQ * 4;
constexpr size_t WS_F32 = WS_MASK + (size_t)BATCH * 64 * SEQ * 8;
constexpr size_t WS_UP = WS_F32 + (size_t)M * DM * 4;
constexpr size_t WS_G = WS_UP + (size_t)M * D_UP * 2;
constexpr size_t WS_RS = WS_G + (size_t)M * D_FF * 2;
constexpr size_t WS_END = WS_RS + 1 * MiB;
static_assert(WS_WIN % 256 == 0 && WS_Z % 256 == 0 && WS_SC % 256 == 0 && WS_UP % 256 == 0 && WS_RS % 256 == 0, "alignment");
constexpr int CW_BAR = 4096;

constexpr int LDS_BYTES = 147456;
constexpr int LDSCTL_OFF = LDS_BYTES - 1024;
constexpr int SCRATCH_BYTES = LDSCTL_OFF;

#define GAS __attribute__((address_space(1)))
#define LAS __attribute__((address_space(3)))
typedef unsigned short bf16;
typedef unsigned v4u __attribute__((ext_vector_type(4)));
typedef unsigned v2u __attribute__((ext_vector_type(2)));
typedef float f32x4 __attribute__((ext_vector_type(4)));
typedef float f32x16 __attribute__((ext_vector_type(16)));
typedef short bf16x8 __attribute__((ext_vector_type(8)));
typedef GAS unsigned gu32;
#define RLX_AGENT __ATOMIC_RELAXED, __HIP_MEMORY_SCOPE_AGENT
#define LDS_WAIT() asm volatile("s_waitcnt lgkmcnt(0)" ::: "memory")
#define VM_WAIT() asm volatile("s_waitcnt vmcnt(0)" ::: "memory")
__device__ __forceinline__ unsigned pk2(float lo, float hi) { unsigned r; asm volatile("v_cvt_pk_bf16_f32 %0, %1, %2" : "=v"(r) : "v"(lo), "v"(hi)); return r; }
__device__ __forceinline__ float bflo(unsigned w) { return __uint_as_float(w << 16); }
__device__ __forceinline__ float bfhi(unsigned w) { return __uint_as_float(w & 0xffff0000u); }
__device__ __forceinline__ float wave_sum(float v) {
#pragma unroll
    for (int o = 1; o < 64; o <<= 1) v += __shfl_xor(v, o);
    return v;
}
#define XB_TMO      128
#define XB_XCNT(j)  (256  + 64 * (j))
#define XB_XSUB(j)  (1280 + 64 * (j))
#define XB_XGEN(j)  (2304 + 64 * (j))
#define XB_TOP      3328
#define XB_TOPGEN   3392
#define XCD_BAR_WORDS 3456
#define XB_SPIN_CAP (1u << 18)

__device__ __forceinline__ unsigned xb_ld(unsigned* p)              { return __hip_atomic_load(p, __ATOMIC_RELAXED, __HIP_MEMORY_SCOPE_AGENT); }
__device__ __forceinline__ unsigned xb_add(unsigned* p, unsigned v) { return __hip_atomic_fetch_add(p, v, __ATOMIC_RELAXED, __HIP_MEMORY_SCOPE_AGENT); }
__device__ __forceinline__ unsigned xb_xcc_id() { return (unsigned)__builtin_amdgcn_s_getreg((3 << 11) | 20) & 0xFu; }
#define XB_SPIN(cond, bar) do { unsigned _sp = 0; while (cond) { __builtin_amdgcn_s_sleep(1); \
    if ((++_sp & 255u) == 0u) { if (xb_ld(&(bar)[XB_TMO])) break; if (_sp > XB_SPIN_CAP) { atomicAdd(&(bar)[XB_TMO], 1u); break; } } } } while (0)

struct XcdBarrier {
    unsigned* bar; unsigned x;
    volatile LAS unsigned* st;
};

__device__ __forceinline__ XcdBarrier xcd_barrier_post(unsigned* bar, volatile LAS unsigned* st) {
    XcdBarrier b; b.bar = bar; b.x = xb_xcc_id(); b.st = st;
    if (threadIdx.x == 0) (void)xb_add(&bar[XB_XCNT(b.x)], 1u);
    return b;
}
__device__ __forceinline__ void xcd_barrier_complete(unsigned* bar, unsigned x, unsigned& nloc, unsigned& nx) {
    const unsigned G = gridDim.x * gridDim.y * gridDim.z;
    unsigned sum, cnt, mine, sp = 0u;
    for (;;) {
        sum = 0u; cnt = 0u; mine = 0u;
#pragma unroll
        for (unsigned j = 0; j < 16; ++j) { const unsigned c = xb_ld(&bar[XB_XCNT(j)]); sum += c; cnt += (c > 0u) ? 1u : 0u; mine = (j == x) ? c : mine; }
        if (sum == G) break;
        __builtin_amdgcn_s_sleep(1);
        if ((++sp & 255u) == 0u) { if (xb_ld(&bar[XB_TMO])) break; if (sp > XB_SPIN_CAP) { atomicAdd(&bar[XB_TMO], 1u); break; } }
    }
    nloc = mine > 0u ? mine : 1u; nx = cnt > 0u ? cnt : 1u;
}

__device__ __forceinline__ void xcd_barrier(const XcdBarrier& b) {
    asm volatile("s_waitcnt vmcnt(0)" ::: "memory");
    __syncthreads();
    if (threadIdx.x == 0) {
        unsigned* bar = b.bar;
        __builtin_amdgcn_s_waitcnt(0);
        unsigned nloc = b.st[0], nx = b.st[1];
        if (nloc == 0u) { xcd_barrier_complete(bar, b.x, nloc, nx); b.st[0] = nloc; b.st[1] = nx; }
        const unsigned old = xb_add(&bar[XB_XSUB(b.x)], 1u);
        const unsigned gen = old / nloc;
        if (old + 1u == (gen + 1u) * nloc) {
            __builtin_amdgcn_fence(__ATOMIC_RELEASE, "agent");
            asm volatile("s_waitcnt vmcnt(0)" ::: "memory");
            const unsigned og = xb_add(&bar[XB_TOP], 1u);
            const unsigned tg = og / nx;
            if (og + 1u == (tg + 1u) * nx) xb_add(&bar[XB_TOPGEN], 1u);
            else XB_SPIN(xb_ld(&bar[XB_TOPGEN]) == tg, bar);
            __builtin_amdgcn_fence(__ATOMIC_ACQUIRE, "agent");
            xb_add(&bar[XB_XGEN(b.x)], 1u);
            asm volatile("s_waitcnt vmcnt(0)" ::: "memory");
        } else {
            XB_SPIN(xb_ld(&bar[XB_XGEN(b.x)]) == gen, bar);
            __builtin_amdgcn_fence(__ATOMIC_ACQUIRE, "agent");
            asm volatile("s_waitcnt vmcnt(0)" ::: "memory");
        }
    }
    __syncthreads();
}

struct Frame {
    LAS unsigned char* lds;
    volatile LAS unsigned* MISC;
    gu32* ctl;
    int tid, lane, wave, vcu, G;
    float* out; unsigned char* ws;
};
struct Args { const float* in[17]; float* out; unsigned char* ws; int ph_lo, ph_hi; };
static_assert(sizeof(Args) == 17 * 8 + 8 + 8 + 8, "Args has no padding");
__device__ __forceinline__ void refresh(Frame& F) { int t = threadIdx.x; asm volatile("" : "+v"(t)); F.tid = t; F.lane = t & 63; F.wave = __builtin_amdgcn_readfirstlane(t >> 6); }
enum { IN_X = 0, IN_WIN, IN_POOLW, IN_POOLS, IN_LNG, IN_LNB, IN_SGUW, IN_SGUB, IN_WOUT, IN_WUP, IN_CONVW, IN_CONVB, IN_WDN, IN_NPM, IN_NQM, IN_NPF, IN_NQF };

__device__ __forceinline__ void p0_transpose_item(const float* W, int K, int Nsrc, const float* gain, bf16* WT, int mode, LAS float* scr, int item, int nblk, int lane) {
    const int kb = item / nblk, nb = item % nblk, k0 = 64 * kb, n0 = 32 * nb;
    const int nd = n0 + (lane & 31);
    int ns = nd;
    if (mode == 1) ns = nd < ZC_PAD ? nd : (nd < ZC_G ? -1 : nd - (ZC_G - ZC_PAD));
#pragma unroll 8
    for (int i = 0; i < 32; ++i) { const int kk = 2 * i + (lane >> 5);
        float v = ns >= 0 ? W[(size_t)(k0 + kk) * Nsrc + ns] : 0.f;
        if (gain) v *= gain[k0 + kk];
        scr[kk * 33 + (lane & 31)] = v; }
    LDS_WAIT(); asm volatile("" ::: "memory");
    const int c = lane & 7;
#pragma unroll
    for (int j = 0; j < 4; ++j) { const int n = (lane >> 3) + 8 * j; const LAS float* s = scr + (8 * c) * 33 + n;
        v4u o; o.x = pk2(s[0 * 33], s[1 * 33]); o.y = pk2(s[2 * 33], s[3 * 33]); o.z = pk2(s[4 * 33], s[5 * 33]); o.w = pk2(s[6 * 33], s[7 * 33]);
        *(GAS v4u*)(WT + (size_t)(n0 + n) * K + k0 + 8 * c) = o; }
    LDS_WAIT(); asm volatile("" ::: "memory");
}
__device__ __forceinline__ void p0_weights(Frame& F, const Args& A) {
    LAS float* scr = (LAS float*)(F.lds + F.wave * 16384);
    const int gw = F.vcu * NWAVES + F.wave, NGW = F.G * NWAVES;
    constexpr int I_IN = (DM / 64) * (ZP / 32), I_OUT = (DM / 64) * (DM / 32), I_UP = (DM / 64) * (D_UP / 32), I_DN = (D_FF / 64) * (DM / 32);
    constexpr int I_LAYER = I_IN + I_OUT + I_UP + I_DN;
    for (int it = gw; it < DEPTH * I_LAYER; it += NGW) {
        const int l = it / I_LAYER; int r = it - l * I_LAYER;
        if (r < I_IN) { p0_transpose_item(A.in[IN_WIN] + (size_t)l * DM * D_IN, DM, D_IN, A.in[IN_NPM] + l * DM, (bf16*)(F.ws + WS_WIN + l * SZ_WIN), 1, scr, r, ZP / 32, F.lane); continue; } r -= I_IN;
        if (r < I_OUT) { p0_transpose_item(A.in[IN_WOUT] + (size_t)l * DM * DM, DM, DM, nullptr, (bf16*)(F.ws + WS_WOUT + l * SZ_WOUT), 0, scr, r, DM / 32, F.lane); continue; } r -= I_OUT;
        if (r < I_UP) { p0_transpose_item(A.in[IN_WUP] + (size_t)l * DM * D_UP, DM, D_UP, A.in[IN_NPF] + l * DM, (bf16*)(F.ws + WS_WUP + l * SZ_WUP), 0, scr, r, D_UP / 32, F.lane); continue; } r -= I_UP;
        p0_transpose_item(A.in[IN_WDN] + (size_t)l * D_FF * DM, D_FF, DM, nullptr, (bf16*)(F.ws + WS_WDN + l * SZ_WDN), 0, scr, r, DM / 32, F.lane);
    }
}
__device__ __forceinline__ void p0_rows(Frame& F, const Args& A) {
    const int gw = F.vcu * NWAVES + F.wave, NGW = F.G * NWAVES;
    const float* x = A.in[IN_X]; bf16* xb = (bf16*)(F.ws + WS_XB); float* RS = (float*)(F.ws + WS_RS);
    for (int m = gw; m < M; m += NGW) {
        const GAS f32x4* xr = (const GAS f32x4*)(x + (size_t)m * DM) + F.lane;
        f32x4 v[8]; float s = 0.f;
#pragma unroll
        for (int j = 0; j < 8; ++j) { v[j] = xr[64 * j]; s += (v[j].x * v[j].x + v[j].y * v[j].y) + (v[j].z * v[j].z + v[j].w * v[j].w); }
        s = wave_sum(s);
        if (F.lane == 0) RS[m] = 1.0f / sqrtf(s * (1.f / DM) + EPS);
        GAS v2u* o8 = (GAS v2u*)(xb + (size_t)m * DM) + F.lane;
#pragma unroll
        for (int j = 0; j < 8; ++j) { v2u w; w.x = pk2(v[j].x, v[j].y); w.y = pk2(v[j].z, v[j].w); o8[64 * j] = w; }
    }
}
__device__ __forceinline__ void thin_phase(Frame& F, const float* y, const float* xin, float* xout, const float* g) {
    const int gw = F.vcu * NWAVES + F.wave, NGW = F.G * NWAVES;
    bf16* xb = (bf16*)(F.ws + WS_XB); float* RS = (float*)(F.ws + WS_RS);
    for (int m = gw; m < M; m += NGW) {
        const GAS f32x4* yr = (const GAS f32x4*)(y + (size_t)m * DM) + F.lane;
        const GAS f32x4* xr = (const GAS f32x4*)(xin + (size_t)m * DM) + F.lane;
        const GAS f32x4* gr = (const GAS f32x4*)g + F.lane;
        f32x4 yv[8], xv[8]; float s = 0.f;
#pragma unroll
        for (int j = 0; j < 8; ++j) { yv[j] = yr[64 * j]; xv[j] = xr[64 * j]; }
#pragma unroll
        for (int j = 0; j < 8; ++j) s += (yv[j].x * yv[j].x + yv[j].y * yv[j].y) + (yv[j].z * yv[j].z + yv[j].w * yv[j].w);
        const float r = 1.0f / sqrtf(wave_sum(s) * (1.f / DM) + EPS);
        float s2 = 0.f;
#pragma unroll
        for (int j = 0; j < 8; ++j) { const f32x4 gg = gr[64 * j]; xv[j] = xv[j] + yv[j] * r * gg;
            s2 += (xv[j].x * xv[j].x + xv[j].y * xv[j].y) + (xv[j].z * xv[j].z + xv[j].w * xv[j].w); }
        s2 = wave_sum(s2);
        if (F.lane == 0) RS[m] = 1.0f / sqrtf(s2 * (1.f / DM) + EPS);
        GAS f32x4* xo = (GAS f32x4*)(xout + (size_t)m * DM) + F.lane;
        GAS v2u* o8 = (GAS v2u*)(xb + (size_t)m * DM) + F.lane;
#pragma unroll
        for (int j = 0; j < 8; ++j) { xo[64 * j] = xv[j]; v2u w; w.x = pk2(xv[j].x, xv[j].y); w.y = pk2(xv[j].z, xv[j].w); o8[64 * j] = w; }
    }
}
__device__ __forceinline__ void unpack8(const v4u r, float (&f)[8]) { f[0] = bflo(r.x); f[1] = bfhi(r.x); f[2] = bflo(r.y); f[3] = bfhi(r.y); f[4] = bflo(r.z); f[5] = bfhi(r.z); f[6] = bflo(r.w); f[7] = bfhi(r.w); }
__device__ __forceinline__ void conv_phase(Frame& F, const Args& A, int l) {
    const int gw = F.vcu * NWAVES + F.wave, NGW = F.G * NWAVES;
    const bf16* UP = (const bf16*)(F.ws + WS_UP); bf16* Gb = (bf16*)(F.ws + WS_G);
    const float* cw = A.in[IN_CONVW] + (size_t)l * 3 * D_UP; const float* cb = A.in[IN_CONVB] + (size_t)l * D_UP;
    constexpr int NCC = D_FF / 512, NRC = M / 16;
    for (int it = gw; it < NCC * NRC; it += NGW) {
        const int cc = it % NCC, rc = it / NCC, r0 = rc * 16, c0 = cc * 512 + F.lane * 8;
        float wg[3][8], wv[3][8], bg[8], bv[8];
#pragma unroll
        for (int j = 0; j < 3; ++j)
#pragma unroll
            for (int h = 0; h < 2; ++h) { const f32x4 a = *(const GAS f32x4*)(cw + (size_t)j * D_UP + c0 + 4 * h), b = *(const GAS f32x4*)(cw + (size_t)j * D_UP + D_FF + c0 + 4 * h);
                wg[j][4 * h] = a.x; wg[j][4 * h + 1] = a.y; wg[j][4 * h + 2] = a.z; wg[j][4 * h + 3] = a.w; wv[j][4 * h] = b.x; wv[j][4 * h + 1] = b.y; wv[j][4 * h + 2] = b.z; wv[j][4 * h + 3] = b.w; }
#pragma unroll
        for (int h = 0; h < 2; ++h) { const f32x4 a = *(const GAS f32x4*)(cb + c0 + 4 * h), b = *(const GAS f32x4*)(cb + D_FF + c0 + 4 * h);
            bg[4 * h] = a.x; bg[4 * h + 1] = a.y; bg[4 * h + 2] = a.z; bg[4 * h + 3] = a.w; bv[4 * h] = b.x; bv[4 * h + 1] = b.y; bv[4 * h + 2] = b.z; bv[4 * h + 3] = b.w; }
        float g2[8], g1[8], v2[8], v1[8];
        if ((r0 & (SEQ - 1)) == 0) {
#pragma unroll
            for (int k = 0; k < 8; ++k) { g2[k] = 0.f; g1[k] = 0.f; v2[k] = 0.f; v1[k] = 0.f; }
        } else {
            unpack8(*(const GAS v4u*)(UP + (size_t)(r0 - 2) * D_UP + c0), g2); unpack8(*(const GAS v4u*)(UP + (size_t)(r0 - 1) * D_UP + c0), g1);
            unpack8(*(const GAS v4u*)(UP + (size_t)(r0 - 2) * D_UP + D_FF + c0), v2); unpack8(*(const GAS v4u*)(UP + (size_t)(r0 - 1) * D_UP + D_FF + c0), v1);
        }
#pragma unroll 4
        for (int i = 0; i < 16; ++i) {
            float g0[8], v0[8], o[8];
            unpack8(*(const GAS v4u*)(UP + (size_t)(r0 + i) * D_UP + c0), g0); unpack8(*(const GAS v4u*)(UP + (size_t)(r0 + i) * D_UP + D_FF + c0), v0);
#pragma unroll
            for (int k = 0; k < 8; ++k) {
                const float cg = bg[k] + wg[0][k] * g2[k] + wg[1][k] * g1[k] + wg[2][k] * g0[k];
                const float cv = bv[k] + wv[0][k] * v2[k] + wv[1][k] * v1[k] + wv[2][k] * v0[k];
                const float sg = cg * __builtin_amdgcn_rcpf(1.0f + __builtin_amdgcn_exp2f(-1.4426950408889634f * cg));
                o[k] = sg * cv; g2[k] = g1[k]; g1[k] = g0[k]; v2[k] = v1[k]; v1[k] = v0[k]; }
            v4u w; w.x = pk2(o[0], o[1]); w.y = pk2(o[2], o[3]); w.z = pk2(o[4], o[5]); w.w = pk2(o[6], o[7]);
            *(GAS v4u*)(Gb + (size_t)(r0 + i) * D_FF + c0) = w;
        }
    }
}
__device__ __forceinline__ void pool_item(Frame& F, const Args& A, int l, int item) {
    const int g = item & 3, tt0 = (item >> 2) * 64, tid = F.tid;
    const bf16* Z = (const bf16*)(F.ws + WS_Z); bf16* MIX = (bf16*)(F.ws + WS_MIX);
    LAS float* Wl = (LAS float*)F.lds;
    LAS float* Pl = (LAS float*)(F.lds + 65536);
    const float* wp = A.in[IN_POOLW] + ((size_t)l * 4 + g) * 128 * 128;
#pragma unroll
    for (int i = 0; i < 8; ++i) { const int idx = (i * 512 + tid) * 4; *(LAS f32x4*)(Wl + idx) = *(const GAS f32x4*)(wp + idx); }
    {
        const int tt = tid >> 3, c16 = (tid & 7) * 16, row = tt0 + tt, t = row & (SEQ - 1), w = 2 << g;
        const int n = (t + 1) < w ? (t + 1) : w;
        float acc[16], cur[16];
        const bf16* p = Z + (size_t)row * ZP + ZC_POOL + g * 128 + c16;
        { float a[8], b[8]; unpack8(*(const GAS v4u*)p, a); unpack8(*(const GAS v4u*)(p + 8), b);
#pragma unroll
          for (int k = 0; k < 8; ++k) { cur[k] = a[k]; cur[8 + k] = b[k]; acc[k] = a[k]; acc[8 + k] = b[k]; } }
        for (int i = 1; i < n; ++i) { float a[8], b[8]; const bf16* q = p - (size_t)i * ZP; unpack8(*(const GAS v4u*)q, a); unpack8(*(const GAS v4u*)(q + 8), b);
#pragma unroll
            for (int k = 0; k < 8; ++k) { acc[k] += a[k]; acc[8 + k] += b[k]; } }
        const float inv = 1.0f / (float)n;
#pragma unroll
        for (int k4 = 0; k4 < 4; ++k4) { f32x4 o; o.x = acc[4 * k4] * inv - cur[4 * k4]; o.y = acc[4 * k4 + 1] * inv - cur[4 * k4 + 1]; o.z = acc[4 * k4 + 2] * inv - cur[4 * k4 + 2]; o.w = acc[4 * k4 + 3] * inv - cur[4 * k4 + 3];
            *(LAS f32x4*)(Pl + tt * 132 + c16 + 4 * k4) = o; }
    }
    __syncthreads();
    {
        const int tt = tid >> 3, dq = tid & 7, row = tt0 + tt;
        f32x4 y[4];
#pragma unroll
        for (int i = 0; i < 4; ++i) y[i] = (f32x4){0.f, 0.f, 0.f, 0.f};
        for (int c4 = 0; c4 < 32; ++c4) {
            const f32x4 p4 = *(const LAS f32x4*)(Pl + tt * 132 + 4 * c4);
#pragma unroll
            for (int cc = 0; cc < 4; ++cc) { const float pv = p4[cc];
#pragma unroll
                for (int i = 0; i < 4; ++i) { const f32x4 w4 = *(const LAS f32x4*)(Wl + (4 * c4 + cc) * 128 + dq * 16 + 4 * i); y[i] = y[i] + w4 * pv; } }
        }
        const float* ps = A.in[IN_POOLS] + (size_t)l * D_POOL + g * 128 + dq * 16;
#pragma unroll
        for (int i = 0; i < 4; ++i) y[i] = y[i] * *(const GAS f32x4*)(ps + 4 * i);
        v4u w0, w1; w0.x = pk2(y[0].x, y[0].y); w0.y = pk2(y[0].z, y[0].w); w0.z = pk2(y[1].x, y[1].y); w0.w = pk2(y[1].z, y[1].w);
        w1.x = pk2(y[2].x, y[2].y); w1.y = pk2(y[2].z, y[2].w); w1.z = pk2(y[3].x, y[3].y); w1.w = pk2(y[3].z, y[3].w);
        bf16* o = MIX + (size_t)row * DM + g * 128 + dq * 16;
        *(GAS v4u*)o = w0; *(GAS v4u*)(o + 8) = w1;
    }
    __syncthreads();
}
__device__ __forceinline__ void gmlp_item(Frame& F, const Args& A, int l, int item) {
    const int g = item & 3, row0 = (item >> 2) * 128, tid = F.tid, lane = F.lane;
    const bf16* Z = (const bf16*)(F.ws + WS_Z); bf16* MIX = (bf16*)(F.ws + WS_MIX);
    LAS float* Vl = (LAS float*)F.lds;
    LAS float* Wl = (LAS float*)(F.lds + 65536);
    const float* wsrc = A.in[IN_SGUW] + ((size_t)l * 4 + g) * 128 * 128;
    { const int t = tid >> 2, s0 = (tid & 3) * 32;
#pragma unroll
      for (int i = 0; i < 8; ++i) { f32x4 w = *(const GAS f32x4*)(wsrc + t * 128 + s0 + 4 * i); const int s = s0 + 4 * i;
          w.x = (s <= t) ? w.x : 0.f; w.y = (s + 1 <= t) ? w.y : 0.f; w.z = (s + 2 <= t) ? w.z : 0.f; w.w = (s + 3 <= t) ? w.w : 0.f;
          *(LAS f32x4*)(Wl + t * 132 + s) = w; } }
    { const float* lg = A.in[IN_LNG] + (size_t)l * D_GMLP + lane * 8; const float* lb = A.in[IN_LNB] + (size_t)l * D_GMLP + lane * 8;
      const f32x4 g0 = *(const GAS f32x4*)lg, g1 = *(const GAS f32x4*)(lg + 4), b0 = *(const GAS f32x4*)lb, b1 = *(const GAS f32x4*)(lb + 4);
      for (int j = 0; j < 16; ++j) { const int s = F.wave * 16 + j, row = row0 + s;
          float x[8]; unpack8(*(const GAS v4u*)(Z + (size_t)row * ZP + ZC_G + D_GMLP + lane * 8), x);
          float sm = 0.f;
#pragma unroll
          for (int k = 0; k < 8; ++k) sm += x[k];
          const float mu = wave_sum(sm) * (1.f / D_GMLP); float q = 0.f;
#pragma unroll
          for (int k = 0; k < 8; ++k) { x[k] -= mu; q += x[k] * x[k]; }
          const float rstd = 1.0f / sqrtf(wave_sum(q) * (1.f / D_GMLP) + EPS);
          if ((lane >> 4) == g) { const int cl = (lane & 15) * 8;
              f32x4 o0, o1; o0.x = x[0] * rstd * g0.x + b0.x; o0.y = x[1] * rstd * g0.y + b0.y; o0.z = x[2] * rstd * g0.z + b0.z; o0.w = x[3] * rstd * g0.w + b0.w;
              o1.x = x[4] * rstd * g1.x + b1.x; o1.y = x[5] * rstd * g1.y + b1.y; o1.z = x[6] * rstd * g1.z + b1.z; o1.w = x[7] * rstd * g1.w + b1.w;
              *(LAS f32x4*)(Vl + s * 128 + cl) = o0; *(LAS f32x4*)(Vl + s * 128 + cl + 4) = o1; } } }
    __syncthreads();
    {
        const int t = tid >> 2, cq = tid & 3, row = row0 + t;
        f32x4 acc[8];
#pragma unroll
        for (int i = 0; i < 8; ++i) acc[i] = (f32x4){0.f, 0.f, 0.f, 0.f};
        const int s4max = (F.wave * 16 + 15) >> 2;
        for (int s4 = 0; s4 <= s4max; ++s4) {
            const f32x4 w4 = *(const LAS f32x4*)(Wl + t * 132 + 4 * s4);
#pragma unroll
            for (int ss = 0; ss < 4; ++ss) { const float wv = w4[ss]; const LAS float* vr = Vl + (4 * s4 + ss) * 128 + cq * 4;
#pragma unroll
                for (int i = 0; i < 8; ++i) acc[i] = acc[i] + *(const LAS f32x4*)(vr + 16 * i) * wv; }
        }
        const float bias = A.in[IN_SGUB][((size_t)l * 4 + g) * 128 + t];
        const bf16* up = Z + (size_t)row * ZP + ZC_G + g * 128 + cq * 4; bf16* o = MIX + (size_t)row * DM + D_POOL + D_ATTN + g * 128 + cq * 4;
#pragma unroll
        for (int i = 0; i < 8; ++i) { const v2u uu = *(const GAS v2u*)(up + 16 * i); const f32x4 mx = acc[i] + bias;
            v2u w; w.x = pk2(bflo(uu.x) * mx.x, bfhi(uu.x) * mx.y); w.y = pk2(bflo(uu.y) * mx.z, bfhi(uu.y) * mx.w); *(GAS v2u*)(o + 16 * i) = w; }
    }
    __syncthreads();
}
__device__ __forceinline__ void idx_phase(Frame& F) {
    constexpr int SPB = 64 * 65 / 2, T = BATCH * SPB;
    const int s_lo = (int)(((long)F.vcu * T) / F.G), s_hi = (int)(((long)(F.vcu + 1) * T) / F.G);
    if (s_lo >= s_hi) return;
    const bf16* Z = (const bf16*)(F.ws + WS_Z); float* SC = (float*)(F.ws + WS_SC);
    const int tid = F.tid, lane = F.lane, r = lane & 31, h = lane >> 5;
    int b = s_lo / SPB, rem = s_lo - b * SPB, j = 0;
    while ((j + 1) * (j + 2) / 2 <= rem) ++j;
    int kt = rem - j * (j + 1) / 2;
    LAS unsigned char* Kl = F.lds;
    const int skey = tid >> 3, schunk = tid & 7, swoff = skey * 128 + ((schunk ^ ((skey >> 1) & 7)) << 4);
    int roff[4];
#pragma unroll
    for (int ks = 0; ks < 4; ++ks) roff[ks] = r * 128 + (((2 * ks + h) ^ ((r >> 1) & 7)) << 4);
    v4u stg = *(const GAS v4u*)(Z + (size_t)(b * SEQ + kt * 64 + skey) * ZP + ZC_KI + schunk * 8);
    *(LAS v4u*)(Kl + swoff) = stg;
    __syncthreads();
    int cur = 0, loaded = -1;
    bf16x8 A[4][4]; float wv[4][16];
    for (int s = s_lo; s < s_hi; ++s) {
        if (b * 64 + j != loaded) {
            loaded = b * 64 + j;
#pragma unroll
            for (int p = 0; p < 4; ++p) {
                const int qa = b * SEQ + j * 64 + F.wave * 8 + 2 * p + ((r >> 2) & 1), head = (r & 3) + 4 * (r >> 3);
#pragma unroll
                for (int ks = 0; ks < 4; ++ks) A[p][ks] = *(const GAS bf16x8*)(Z + (size_t)qa * ZP + ZC_QI + head * 64 + 16 * ks + 8 * h);
                const int qw = b * SEQ + j * 64 + F.wave * 8 + 2 * p + h;
                float w0[8], w1[8]; unpack8(*(const GAS v4u*)(Z + (size_t)qw * ZP + ZC_WI), w0); unpack8(*(const GAS v4u*)(Z + (size_t)qw * ZP + ZC_WI + 8), w1);
#pragma unroll
                for (int k = 0; k < 8; ++k) { wv[p][k] = w0[k] * 0.03125f; wv[p][8 + k] = w1[k] * 0.03125f; }
            }
        }
        int nb = b, nj = j, nkt = kt + 1;
        if (nkt > nj) { nkt = 0; ++nj; if (nj == 64) { nj = 0; ++nb; } }
        const bool has_next = s + 1 < s_hi;
        if (has_next) stg = *(const GAS v4u*)(Z + (size_t)(nb * SEQ + nkt * 64 + skey) * ZP + ZC_KI + schunk * 8);
#pragma unroll
        for (int kb = 0; kb < 2; ++kb) {
            bf16x8 Bf[4];
#pragma unroll
            for (int ks = 0; ks < 4; ++ks) Bf[ks] = *(const LAS bf16x8*)(Kl + cur * 8192 + kb * 4096 + roff[ks]);
#pragma unroll
            for (int p = 0; p < 4; ++p) {
                f32x16 acc = {};
#pragma unroll
                for (int ks = 0; ks < 4; ++ks) acc = __builtin_amdgcn_mfma_f32_32x32x16_bf16(A[p][ks], Bf[ks], acc, 0, 0, 0);
                float sc = 0.f;
#pragma unroll
                for (int i = 0; i < 16; ++i) sc += wv[p][i] * fmaxf(acc[i], 0.f);
                const int q = j * 64 + F.wave * 8 + 2 * p + h;
                SC[(size_t)(b * SEQ + q) * SEQ + kt * 64 + kb * 32 + r] = sc;
            }
        }
        if (has_next) *(LAS v4u*)(Kl + (cur ^ 1) * 8192 + swoff) = stg;
        __syncthreads();
        cur ^= 1; b = nb; j = nj; kt = nkt;
    }
}
__device__ __forceinline__ int wave_isum(int v) {
#pragma unroll
    for (int o = 1; o < 64; o <<= 1) v += __shfl_xor(v, o);
    return v;
}
__device__ __forceinline__ void select_phase(Frame& F) {
    const float* SC = (const float*)(F.ws + WS_SC); unsigned long long* MASKT = (unsigned long long*)(F.ws + WS_MASK);
    LAS unsigned long long* Ml = (LAS unsigned long long*)F.lds;
    const int lane = F.lane;
    for (int pr = F.vcu; pr < M / 32; pr += F.G) {
#pragma unroll 1
        for (int gq = 0; gq < 4; ++gq) {
            const int gi = gq >> 1, qi = gq & 1, grp = gi ? (M / 16 - 1 - pr) : pr;
            const int ql = F.wave * 2 + qi, row = grp * 16 + ql, t = row & (SEQ - 1), jmax = (t >> 6) + 1;
            const float* sr = SC + (size_t)row * SEQ + lane;
            unsigned u[64];
#pragma unroll
            for (int j = 0; j < 64; ++j) {
                unsigned v = 0u;
                if (j < jmax) { const unsigned bits = __float_as_uint(sr[64 * j]); const unsigned key = (bits & 0x80000000u) ? ~bits : (bits | 0x80000000u); v = (64 * j + lane <= t) ? key : 0u; }
                u[j] = v;
            }
            unsigned T = 1u; bool exact = true;
            if (t + 1 > TOPK) {
                T = 0u; exact = false;
                for (int bit = 31; bit >= 0; --bit) {
                    const unsigned cand = T | (1u << bit); int cl = 0;
#pragma unroll
                    for (int j = 0; j < 64; ++j) cl += (u[j] >= cand) ? 1 : 0;
                    const int c = __builtin_amdgcn_readfirstlane(wave_isum(cl));
                    if (c >= TOPK) { T = cand; if (c == TOPK) { exact = true; break; } }
                }
            }
            int need = 0;
            if (!exact) { int cl = 0;
#pragma unroll
                for (int j = 0; j < 64; ++j) cl += (u[j] > T) ? 1 : 0;
                need = TOPK - __builtin_amdgcn_readfirstlane(wave_isum(cl)); }
            unsigned mlo = 0u, mhi = 0u;
#pragma unroll
            for (int j = 0; j < 64; ++j) {
                unsigned long long wd = 0ull;
                if (j < jmax) {
                    if (exact) wd = __ballot(u[j] >= T);
                    else { wd = __ballot(u[j] > T); unsigned long long me = __ballot(u[j] == T);
                        if (me != 0ull && need > 0) { int pc = __popcll(me);
                            if (pc > need) { unsigned long long keep = 0ull; for (int k = 0; k < need; ++k) { const unsigned long long low = me & (0ull - me); keep |= low; me ^= low; } me = keep; pc = need; }
                            wd |= me; need -= pc; } }
                }
                { const unsigned wl_ = (unsigned)wd, wh_ = (unsigned)(wd >> 32); asm volatile("v_writelane_b32 %0, %2, %4\n\tv_writelane_b32 %1, %3, %4" : "+v"(mlo), "+v"(mhi) : "s"(wl_), "s"(wh_), "i"(j)); }
                if ((j & 3) == 3) __builtin_amdgcn_sched_barrier(0);
            }
            Ml[(gi * 16 + ql) * 64 + lane] = ((unsigned long long)mhi << 32) | mlo;
        }
        __syncthreads();
        { const int tid = F.tid, gi = tid >> 8, j = (tid >> 2) & 63, q4 = (tid & 3) * 4, grp = gi ? (M / 16 - 1 - pr) : pr, row = grp * 16 + q4, bb = row >> 12, t0 = row & (SEQ - 1);
          unsigned long long w0 = Ml[(gi * 16 + q4 + 0) * 64 + j], w1 = Ml[(gi * 16 + q4 + 1) * 64 + j], w2 = Ml[(gi * 16 + q4 + 2) * 64 + j], w3 = Ml[(gi * 16 + q4 + 3) * 64 + j];
          unsigned long long* dst = MASKT + ((size_t)bb * 64 + j) * SEQ + t0;
          typedef unsigned long long u64x2 __attribute__((ext_vector_type(2)));
          *(GAS u64x2*)dst = (u64x2){w0, w1}; *(GAS u64x2*)(dst + 2) = (u64x2){w2, w3}; }
        __syncthreads();
    }
}
__device__ __forceinline__ att::BlockRef attn_ref(int item, int pass) {
    const int bh = item >> 3, x = item & 7, bb = bh >> 3, hh = bh & 7, qb = pass ? 15 - x : x, P0 = qb * 256; const unsigned row0 = (unsigned)(bb * SEQ + P0);
    att::BlockRef r;
    r.qo = (row0 * ZP + ZC_Q + hh * HD) * 2u; r.ko = ((unsigned)(bb * SEQ) * ZP + ZC_K + hh * HD) * 2u; r.vo = ((unsigned)(bb * SEQ) * ZP + ZC_V + hh * HD) * 2u;
    r.oo = (row0 * DM + D_POOL + hh * HD) * 2u; r.mo = ((unsigned)(bb * 64) * SEQ + P0) * 8u; r.P0 = P0;
    return r;
}
__device__ __forceinline__ void attn_phase(Frame& F, char* lds) {
    constexpr int NITEMS = BATCH * NH * 8;
    if (F.vcu & 1) return;
    int L = F.vcu >> 1; const int stride = F.G >> 1 > 0 ? F.G >> 1 : 1;
    if (L >= NITEMS) return;
    att::Res R;
    R.z = __builtin_amdgcn_make_buffer_rsrc((void*)(F.ws + WS_Z), 0, (int)((size_t)M * ZP * 2), 0x00020000);
    R.mix = __builtin_amdgcn_make_buffer_rsrc((void*)(F.ws + WS_MIX), 0, (int)((size_t)M * DM * 2), 0x00020000);
    R.mk = __builtin_amdgcn_make_buffer_rsrc((void*)(F.ws + WS_MASK), 0, (int)((size_t)BATCH * 64 * SEQ * 8), 0x00020000);
    int pass = 0;
    att::BlockRef cur = attn_ref(L, 0);
    att::Seam S;
    att::prime(R, cur, lds, S);
    for (;;) {
        const bool more_pass = pass == 0, more_item = L + stride < NITEMS, last = !more_pass && !more_item;
        int passn = pass + 1, Ln = L;
        if (!more_pass) { passn = 0; Ln = more_item ? L + stride : L; }
        const att::BlockRef nxt = last ? cur : attn_ref(Ln, passn);
        att::block(R, cur, nxt, lds, S);
        if (last) break;
        cur = nxt; pass = passn; L = Ln;
    }
}

constexpr int N_PHASES = 1 + 6 * 2 * DEPTH;
__host__ __device__ inline bool phase_exists(int ph) { if (ph == 0) return true; const int r = (ph - 1) % 6, hl = (ph - 1) / 6; return !((hl & 1) && (r == 2 || r == 3)); }

__global__ void __launch_bounds__(NWAVES * 64, 2) mega(Args args) {
    extern __shared__ __attribute__((aligned(16))) unsigned char lds[];
    Frame F;
    F.lds = (LAS unsigned char*)lds;
    F.MISC = (volatile LAS unsigned*)(F.lds + LDSCTL_OFF);
    F.tid = threadIdx.x; F.lane = F.tid & 63; F.wave = __builtin_amdgcn_readfirstlane(F.tid >> 6);
    F.G = gridDim.x; { const int bx = blockIdx.x; F.vcu = (F.G % 8 == 0) ? (bx % 8) * (F.G / 8) + bx / 8 : bx; }
    F.ws = args.ws; F.out = args.out; F.ctl = (gu32*)(args.ws + WS_CTL);
    for (int u = F.tid; u < (LDS_BYTES - LDSCTL_OFF) / 4; u += NWAVES * 64) ((LAS unsigned*)(F.lds + LDSCTL_OFF))[u] = 0u;
    __syncthreads();
    const int lo = args.ph_lo, hi = args.ph_hi;
    XcdBarrier bar; bar.bar = (unsigned*)(F.ctl + CW_BAR); bar.x = 0; bar.st = F.MISC + 8;
    if (hi - lo > 1) bar = xcd_barrier_post((unsigned*)(F.ctl + CW_BAR), F.MISC + 8);
#define IN(k) (lo <= (k) && (k) < hi)
#define SEAM(k) do { if (IN(k) && IN((k) + 1)) xcd_barrier(bar); } while (0)

    #if !defined(ONLY) || ONLY==0
    if (IN(0)) { refresh(F); p0_weights(F, args); p0_rows(F, args); }
#endif
    SEAM(0);

    for (int hl = 0; hl < 2 * DEPTH; ++hl) {
        { unsigned long long w_ = (unsigned long long)args.ws; asm volatile("" : "+s"(w_)); F.ws = (unsigned char*)(GAS unsigned char*)w_; }
        const int l = hl >> 1, ffn = hl & 1, pb = 1 + 6 * hl;
#if !defined(ONLY) || ONLY==1
        if (IN(pb + 0)) {
            pg8::Gemm g; g.A = (const bf16*)(F.ws + WS_XB); g.M = M; g.K = DM;
            pg8::EpiRowScaleBf16 E; E.rs = (const float*)(F.ws + WS_RS);
            if (!ffn) { g.Bt = (const bf16*)(F.ws + WS_WIN + l * SZ_WIN); g.N = ZP; E.O = (bf16*)(F.ws + WS_Z); E.ldc = ZP; E.gelu_pn0 = GELU_PN0; }
            else { g.Bt = (const bf16*)(F.ws + WS_WUP + l * SZ_WUP); g.N = D_UP; E.O = (bf16*)(F.ws + WS_UP); E.ldc = D_UP; E.gelu_pn0 = 1 << 30; }
            pg8::StaticOrder S; S.init(g.M, g.N, F.G, (int)blockIdx.x);
            pg8::gemm_phase<pg8::EpiRowScaleBf16, pg8::StaticOrder, true, true>(F.lds, g, S, E);
        }
#endif
        SEAM(pb + 0);
        if (IN(pb + 1)) {
            refresh(F);
            if (!ffn) {
#if !defined(ONLY) || ONLY==2
                for (int it = F.vcu; it < 4 * (M / 64); it += F.G) pool_item(F, args, l, it);
#endif
#if !defined(ONLY) || ONLY==3
                for (int it = F.vcu; it < 4 * (M / CHUNK); it += F.G) gmlp_item(F, args, l, it);
#endif
#if !defined(ONLY) || ONLY==4
                idx_phase(F);
#endif
            } else {
#if !defined(ONLY) || ONLY==5
                conv_phase(F, args, l);
#endif
            }
        }
        SEAM(pb + 1);
        if (!ffn) {
#if !defined(ONLY) || ONLY==6
            if (IN(pb + 2)) { refresh(F); select_phase(F); }
#endif
            SEAM(pb + 2);
#if !defined(ONLY) || ONLY==7
            if (IN(pb + 3)) { refresh(F); attn_phase(F, (char*)lds); }
#endif
            SEAM(pb + 3);
        }
#if !defined(ONLY) || ONLY==8
        if (IN(pb + 4)) {
            pg8::Gemm g; g.M = M; g.N = DM;
            if (!ffn) { g.A = (const bf16*)(F.ws + WS_MIX); g.Bt = (const bf16*)(F.ws + WS_WOUT + l * SZ_WOUT); g.K = DM; }
            else { g.A = (const bf16*)(F.ws + WS_G); g.Bt = (const bf16*)(F.ws + WS_WDN + l * SZ_WDN); g.K = D_FF; }
            pg8::EpiF32 E; E.C = (float*)(F.ws + WS_F32); E.ldc = DM;
            pg8::StaticOrder S; S.init(g.M, g.N, F.G, (int)blockIdx.x);
            pg8::gemm_phase<pg8::EpiF32, pg8::StaticOrder, true, true>(F.lds, g, S, E);
        }
#endif
        SEAM(pb + 4);
#if !defined(ONLY) || ONLY==9
        if (IN(pb + 5)) {
            refresh(F);
            const float* xin = (hl == 0) ? args.in[IN_X] : (const float*)F.out;
            const float* gp = (ffn ? args.in[IN_NQF] : args.in[IN_NQM]) + (size_t)l * DM;
            thin_phase(F, (const float*)(F.ws + WS_F32), xin, F.out, gp);
        }
#endif
        SEAM(pb + 5);
    }
#undef IN
#undef SEAM
}

extern "C" void kernel_launch(void* const* d_in, const int* in_sizes, int n_in, void* d_out, int out_size, void* d_ws, size_t ws_size, hipStream_t stream) {
    static int grid = 0;
    if (grid == 0) {
        if (n_in != 17 || in_sizes[0] != M * DM || out_size != M * DM || ws_size < WS_END) {
            fprintf(stderr, "kernel_launch: built for 17 inputs, x/out of %d floats, >= %zu bytes of workspace; got n_in %d, in0 %d, out %d, ws %zu; nothing launched\n", M * DM, (size_t)WS_END, n_in, n_in > 0 ? in_sizes[0] : -1, out_size, ws_size);
            grid = -1; return; }
        int dev = 0, cus = 0, per_cu = 0;
        if (hipGetDevice(&dev) != hipSuccess || hipDeviceGetAttribute(&cus, hipDeviceAttributeMultiprocessorCount, dev) != hipSuccess) { fprintf(stderr, "kernel_launch: device query failed\n"); grid = -1; return; }
        if (hipFuncSetAttribute((const void*)mega, hipFuncAttributeMaxDynamicSharedMemorySize, LDS_BYTES) != hipSuccess) { fprintf(stderr, "kernel_launch: hipFuncSetAttribute failed\n"); grid = -1; return; }
        if (hipOccupancyMaxActiveBlocksPerMultiprocessor(&per_cu, (const void*)mega, NWAVES * 64, LDS_BYTES) != hipSuccess || per_cu < 1) {
            fprintf(stderr, "kernel_launch: occupancy query reports %d workgroups per CU\n", per_cu); per_cu = 1; }
        (void)hipGetLastError();
        grid = cus;
    }
    if (grid < 0) return;
    if (hipMemsetAsync((char*)d_ws + WS_CTL, 0, CTL_ZERO_BYTES, stream) != hipSuccess) { fprintf(stderr, "kernel_launch: memset failed\n"); return; }
    Args a{};
    for (int i = 0; i < 17; ++i) a.in[i] = (const float*)d_in[i];
    a.out = (float*)d_out; a.ws = (unsigned char*)d_ws;
#if MK_MULTI
    for (int ph = 0; ph < N_PHASES; ++ph) {
        if (!phase_exists(ph)) continue;
        a.ph_lo = ph; a.ph_hi = ph + 1;
        hipLaunchKernelGGL(mega, dim3(grid), dim3(NWAVES * 64), LDS_BYTES, stream, a);
    }
#else
    a.ph_lo = 0; a.ph_hi = N_PHASES;
    hipLaunchKernelGGL(mega, dim3(grid), dim3(NWAVES * 64), LDS_BYTES, stream, a);
#endif
    const hipError_t le = hipPeekAtLastError();
    if (le != hipSuccess) fprintf(stderr, "kernel_launch: launch failed: %s\n", hipGetErrorName(le));
}
```

```cpp
#include <hip/hip_runtime.h>
#include <cstdio>
#include <cstdint>

#ifndef MK_MULTI
#define MK_MULTI 0
#endif
namespace pg8 {
#define PG8_LAS __attribute__((address_space(3)))
typedef unsigned short bf16_t;
typedef short bf16x8 __attribute__((ext_vector_type(8)));
typedef float f32x4 __attribute__((ext_vector_type(4)));
typedef unsigned u32x4 __attribute__((ext_vector_type(4)));
constexpr int BM = 256, BK = 64, HALF = 128, HTB = HALF * BK * 2  , STAGE_BYTES = 8 * HTB, NXCD = 8, WGM = 8;

__host__ __device__ __forceinline__ int lds_byte(int r, int c) { const int st = (r >> 4) * 2 + (c >> 5), rr = r & 15, cc = c & 31, ob = rr * 64 + cc * 2; return st * 1024 + (ob ^ (((ob >> 9) & 1) << 5)); }
__host__ __device__ __forceinline__ void stage_rc(int b, int& R, int& C) { const int st = b / 1024, sb = b % 1024, swz = sb ^ (((sb >> 9) & 1) << 5); R = (st >> 1) * 16 + swz / 64; C = (st & 1) * 32 + (swz % 64) / 2; }
__host__ __device__ __forceinline__ int perm32(int rho) { const int n = rho >> 4, i = rho & 15; return 8 * (i >> 2) + 4 * n + (i & 3); }

struct Unit { int pm, pn; };
struct Gemm { const bf16_t* A; const bf16_t* Bt; int M, N, K; };

struct StaticOrder {
    int nM, nN, nwg, G, c;
    __host__ __device__ void init(int M, int N, int G_, int c_) { nM = M / BM; nN = N / BM; nwg = nM * nN; G = G_; c = c_; }
    __host__ __device__ bool next(int i, Unit& u) const {
        const long L = (long)i * G + c; if (L >= nwg) return false;
        int wgid = (int)L; { const int q = nwg / NXCD, r = nwg % NXCD, xcd = wgid % NXCD, off = wgid / NXCD; wgid = (xcd < r ? xcd * (q + 1) : r * (q + 1) + (xcd - r) * q) + off; }
        const int nig = WGM * nN, gid = wgid / nig, fm = gid * WGM, gsz = (nM - fm) < WGM ? (nM - fm) : WGM;
        u.pm = fm + ((wgid % nig) % gsz); u.pn = (wgid % nig) / gsz; return true;
    }
    __device__ __forceinline__ void a_ready(const Unit&) const {}
    __device__ __forceinline__ void done(const Unit&) const {}
};

__device__ __forceinline__ unsigned cvt_pk_bf16(float lo, float hi) { unsigned r; asm volatile("v_cvt_pk_bf16_f32 %0, %1, %2" : "=v"(r) : "v"(lo), "v"(hi)); return r; }
__device__ __forceinline__ float gelu_tanh(float x) {
    const float u = x * (1.0f + 0.044715f * x * x);
    const float e = __builtin_amdgcn_exp2f(u * (-2.0f * 0.7978845608028654f * 1.4426950408889634f));
    return x * __builtin_amdgcn_rcpf(1.0f + e);
}
struct EpiRowScaleBf16 {
    static constexpr bool PERM = true, AFTER_DRAIN = false;
    bf16_t* O; int ldc; const float* rs; int gelu_pn0;
    __device__ __forceinline__ void operator()(const f32x4 (&acc)[2][2][4][2], const Unit& u, int wr, int wc, int fr, int fq) const {
        const int row0 = u.pm * BM + wr * 64 + fr, col0 = u.pn * BM + wc * 32 + 8 * fq;
        const bool g = u.pn >= gelu_pn0;
#pragma unroll
        for (int ai = 0; ai < 2; ++ai)
#pragma unroll
            for (int m = 0; m < 4; ++m) { const int row = row0 + ai * HALF + m * 16; const float s = rs[row]; bf16_t* rowp = O + (size_t)row * ldc + col0;
#pragma unroll
                for (int bj = 0; bj < 2; ++bj) { f32x4 v0 = acc[ai][bj][m][0] * s, v1 = acc[ai][bj][m][1] * s;
                    if (g) {
#pragma unroll
                        for (int j = 0; j < 4; ++j) { v0[j] = gelu_tanh(v0[j]); v1[j] = gelu_tanh(v1[j]); } }
                    u32x4 w; w.x = cvt_pk_bf16(v0[0], v0[1]); w.y = cvt_pk_bf16(v0[2], v0[3]); w.z = cvt_pk_bf16(v1[0], v1[1]); w.w = cvt_pk_bf16(v1[2], v1[3]);
                    *(u32x4*)(rowp + bj * HALF) = w; } }
    }
};
struct EpiF32 {
    static constexpr bool PERM = false, AFTER_DRAIN = false;
    float* C; int ldc;
    __device__ __forceinline__ void operator()(const f32x4 (&acc)[2][2][4][2], const Unit& u, int wr, int wc, int fr, int fq) const {
        const int row0 = u.pm * BM + wr * 64 + fr, col0 = u.pn * BM + wc * 32 + 4 * fq;
#pragma unroll
        for (int ai = 0; ai < 2; ++ai)
#pragma unroll
            for (int m = 0; m < 4; ++m) { float* rowp = C + (size_t)(row0 + ai * HALF + m * 16) * ldc + col0;
#pragma unroll
                for (int bj = 0; bj < 2; ++bj)
#pragma unroll
                    for (int n = 0; n < 2; ++n) *(f32x4*)(rowp + bj * HALF + n * 16) = acc[ai][bj][m][n]; }
    }
};

template <class Epi, class Sched, bool ALIGN_EPI = false, bool SP2 = false>
__device__ __forceinline__ void gemm_phase(PG8_LAS unsigned char* lds, const Gemm g, const Sched& S, const Epi& E) {
    int tid_ = threadIdx.x; asm volatile("" : "+v"(tid_)); const int tid = tid_, wid = __builtin_amdgcn_readfirstlane(tid >> 6), lane = tid & 63, wr = wid >> 2, wc = wid & 3, fr = lane & 15, fq = lane >> 4;
    const int K = g.K, nt = K / BK;
    unsigned voffA[2], voffB[2];
#pragma unroll
    for (int i = 0; i < 2; ++i) { int R, C; stage_rc(tid * 16 + i * 8192, R, C); const int Rb = Epi::PERM ? ((R & ~31) + perm32(R & 31)) : R;
        voffA[i] = (unsigned)(R * K + C) * 2u; voffB[i] = (unsigned)(Rb * K + C) * 2u; }
    const size_t kstep = (size_t)(BK * 2);
    const size_t hstep = (size_t)HALF * K * 2;
    const size_t tstep = 2 * hstep;
    const unsigned ldsw = (unsigned)wid * 1024u;
    const int aoff = lds_byte(wr * 64 + fr, fq * 8), boff = lds_byte(wc * 32 + fr, fq * 8);
#define PG8_SA(b, h) (((b) * 2 + (h)) * HTB)
#define PG8_SB(b, h) ((4 + (b) * 2 + (h)) * HTB)
#define PG8_STAGE(bufoff, gbase, voff) do { _Pragma("unroll") for (int _i = 0; _i < 2; ++_i) \
        __builtin_amdgcn_global_load_lds((const unsigned*)((const char*)(gbase) + (voff)[_i]), (PG8_LAS unsigned*)(lds + (bufoff) + ldsw + _i * 8192), 16, 0, 0); } while (0)
#define PG8_LDA(dst, b, h) do { _Pragma("unroll") for (int m = 0; m < 4; ++m) _Pragma("unroll") for (int k = 0; k < 2; ++k) dst[m][k] = *(const PG8_LAS bf16x8*)(lds + PG8_SA(b, h) + aoff + m * 2048 + k * 1024); } while (0)
#define PG8_LDB(dst, b, h) do { _Pragma("unroll") for (int n = 0; n < 2; ++n) _Pragma("unroll") for (int k = 0; k < 2; ++k) dst[n][k] = *(const PG8_LAS bf16x8*)(lds + PG8_SB(b, h) + boff + n * 2048 + k * 1024); } while (0)
#define PG8_MMA(ai, bj, At, Bt) do { __builtin_amdgcn_s_setprio(1); _Pragma("unroll") for (int m = 0; m < 4; ++m) _Pragma("unroll") for (int n = 0; n < 2; ++n) _Pragma("unroll") for (int k = 0; k < 2; ++k) \
        acc[ai][bj][m][n] = __builtin_amdgcn_mfma_f32_16x16x32_bf16(Bt[n][k], At[m][k], acc[ai][bj][m][n], 0, 0, 0); __builtin_amdgcn_s_setprio(0); } while (0)
#define PG8_WAIT_V(n) asm volatile("s_waitcnt vmcnt(" #n ")" ::: "memory")
#define PG8_WAIT_L(n) asm volatile("s_waitcnt lgkmcnt(" #n ")" ::: "memory")
#define PG8_BAR __builtin_amdgcn_s_barrier()
#define PG8_SCHED __builtin_amdgcn_sched_barrier(0)
    Unit cur, nxt; int ui = 0;
    if (!S.next(0, cur)) return;
    f32x4 acc[2][2][4][2];
#pragma unroll
    for (int a = 0; a < 2; ++a)
#pragma unroll
        for (int b = 0; b < 2; ++b)
#pragma unroll
            for (int m = 0; m < 4; ++m)
#pragma unroll
                for (int n = 0; n < 2; ++n) acc[a][b][m][n] = (f32x4){0.f, 0.f, 0.f, 0.f};
    bf16x8 At[4][2], B0[2][2], B1[2][2];
    const char* cA = (const char*)g.A + (size_t)cur.pm * tstep; const char* cB = (const char*)g.Bt + (size_t)cur.pn * tstep;
    S.a_ready(cur);
    if constexpr (SP2) {
        PG8_STAGE(PG8_SB(0, 0), cB, voffB); PG8_STAGE(PG8_SB(0, 1), cB + hstep, voffB); PG8_STAGE(PG8_SA(0, 0), cA, voffA); PG8_STAGE(PG8_SA(0, 1), cA + hstep, voffA);
        if (wr == 1) PG8_BAR;
        PG8_WAIT_V(2); PG8_BAR;
        PG8_STAGE(PG8_SB(1, 0), cB + kstep, voffB); PG8_STAGE(PG8_SA(1, 0), cA + kstep, voffA); PG8_STAGE(PG8_SB(1, 1), cB + hstep + kstep, voffB);
        PG8_WAIT_V(6); PG8_BAR;
    } else {
        PG8_STAGE(PG8_SB(0, 0), cB, voffB); PG8_STAGE(PG8_SA(0, 0), cA, voffA); PG8_STAGE(PG8_SB(0, 1), cB + hstep, voffB); PG8_STAGE(PG8_SA(0, 1), cA + hstep, voffA);
        if (wr == 1) PG8_BAR;
        PG8_WAIT_V(4); PG8_BAR;
        PG8_STAGE(PG8_SB(1, 0), cB + kstep, voffB); PG8_STAGE(PG8_SA(1, 0), cA + kstep, voffA); PG8_STAGE(PG8_SB(1, 1), cB + hstep + kstep, voffB);
        PG8_WAIT_V(6); PG8_BAR;
    }
    for (;;) {
        const bool has_next = S.next(ui + 1, nxt);
        const char* nA = has_next ? (const char*)g.A + (size_t)nxt.pm * tstep : cA; const char* nB = has_next ? (const char*)g.Bt + (size_t)nxt.pn * tstep : cB;
        for (int t = 0; t < nt; t += 2) {
            const bool last = (t == nt - 2);
            const char* a1 = cA + (size_t)(t + 1) * kstep;
            const char* a2 = last ? nA : cA + (size_t)(t + 2) * kstep; const char* b2 = last ? nB : cB + (size_t)(t + 2) * kstep;
            const char* a3 = a2 + kstep; const char* b3 = b2 + kstep;
            if (last && has_next) S.a_ready(nxt);
            if constexpr (SP2) {
            PG8_LDB(B0, 0, 0); PG8_LDB(B1, 0, 1); PG8_SCHED; PG8_LDA(At, 0, 0); PG8_STAGE(PG8_SA(1, 1), a1 + hstep, voffA);
            PG8_WAIT_V(8); PG8_WAIT_L(0); PG8_BAR; PG8_MMA(0, 0, At, B0); PG8_MMA(0, 1, At, B1); PG8_BAR; PG8_SCHED;
            PG8_LDA(At, 0, 1); PG8_STAGE(PG8_SB(0, 0), b2, voffB); PG8_STAGE(PG8_SB(0, 1), b2 + hstep, voffB); PG8_STAGE(PG8_SA(0, 0), a2, voffA);
            PG8_WAIT_V(8); PG8_WAIT_L(0); PG8_BAR; PG8_MMA(1, 0, At, B0); PG8_MMA(1, 1, At, B1); PG8_BAR; PG8_SCHED;
            PG8_LDB(B0, 1, 0); PG8_LDB(B1, 1, 1); PG8_SCHED; PG8_LDA(At, 1, 0); PG8_STAGE(PG8_SA(0, 1), a2 + hstep, voffA);
            PG8_WAIT_V(8); PG8_WAIT_L(0); PG8_BAR; PG8_MMA(0, 0, At, B0); PG8_MMA(0, 1, At, B1); PG8_BAR; PG8_SCHED;
            PG8_LDA(At, 1, 1); PG8_STAGE(PG8_SB(1, 0), b3, voffB); PG8_STAGE(PG8_SB(1, 1), b3 + hstep, voffB); PG8_STAGE(PG8_SA(1, 0), a3, voffA);
            PG8_WAIT_V(8); PG8_WAIT_L(0); PG8_BAR; PG8_MMA(1, 0, At, B0); PG8_MMA(1, 1, At, B1); PG8_BAR; PG8_SCHED;
            } else {
            PG8_LDB(B0, 0, 0); PG8_SCHED; PG8_LDA(At, 0, 0); PG8_STAGE(PG8_SA(1, 1), a1 + hstep, voffA);
            PG8_WAIT_L(8); PG8_BAR; PG8_WAIT_L(0); PG8_MMA(0, 0, At, B0); PG8_BAR; PG8_SCHED;
            PG8_LDB(B1, 0, 1); PG8_STAGE(PG8_SB(0, 0), b2, voffB);
            PG8_BAR; PG8_WAIT_L(0); PG8_MMA(0, 1, At, B1); PG8_BAR;
            PG8_LDA(At, 0, 1); PG8_STAGE(PG8_SA(0, 0), a2, voffA);
            PG8_BAR; PG8_WAIT_L(0); PG8_MMA(1, 0, At, B0); PG8_BAR; PG8_SCHED;
            PG8_STAGE(PG8_SB(0, 1), b2 + hstep, voffB);
            PG8_WAIT_V(6); PG8_BAR; PG8_MMA(1, 1, At, B1); PG8_BAR;
            PG8_LDB(B0, 1, 0); PG8_SCHED; PG8_LDA(At, 1, 0); PG8_STAGE(PG8_SA(0, 1), a2 + hstep, voffA);
            PG8_WAIT_L(8); PG8_BAR; PG8_WAIT_L(0); PG8_MMA(0, 0, At, B0); PG8_BAR; PG8_SCHED;
            PG8_LDB(B1, 1, 1); PG8_STAGE(PG8_SB(1, 0), b3, voffB);
            PG8_BAR; PG8_WAIT_L(0); PG8_MMA(0, 1, At, B1); PG8_BAR;
            PG8_LDA(At, 1, 1); PG8_STAGE(PG8_SA(1, 0), a3, voffA);
            PG8_BAR; PG8_WAIT_L(0); PG8_MMA(1, 0, At, B0); PG8_BAR; PG8_SCHED;
            PG8_STAGE(PG8_SB(1, 1), b3 + hstep, voffB);
            PG8_WAIT_V(6); PG8_BAR; PG8_MMA(1, 1, At, B1); PG8_BAR;
            }
        }
        if constexpr (ALIGN_EPI) { if (wr == 0) PG8_BAR; }
        if constexpr (!Epi::AFTER_DRAIN) { E(acc, cur, wr, wc, fr, fq); S.done(cur); }
        if (!has_next) break;
#pragma unroll
        for (int a = 0; a < 2; ++a)
#pragma unroll
            for (int b = 0; b < 2; ++b)
#pragma unroll
                for (int m = 0; m < 4; ++m)
#pragma unroll
                    for (int n = 0; n < 2; ++n) acc[a][b][m][n] = (f32x4){0.f, 0.f, 0.f, 0.f};
        cur = nxt; cA = nA; cB = nB; ++ui;
        if constexpr (ALIGN_EPI) { if (wr == 1) PG8_BAR; }
    }
    PG8_WAIT_V(0);
    if constexpr (!ALIGN_EPI) { if (wr == 0) PG8_BAR; }
    PG8_BAR;
    if constexpr (Epi::AFTER_DRAIN) { E.fused(acc, cur, wr, wc, fr, fq, lds, wid, lane); S.done(cur); }
#undef PG8_SA
#undef PG8_SB
#undef PG8_STAGE
#undef PG8_LDA
#undef PG8_LDB
#undef PG8_MMA
#undef PG8_WAIT_V
#undef PG8_WAIT_L
#undef PG8_BAR
#undef PG8_SCHED
}
}

namespace att {
typedef unsigned short bf16;
typedef short bf16x8 __attribute__((ext_vector_type(8)));
typedef short s16x4 __attribute__((ext_vector_type(4)));
typedef float f32x16 __attribute__((ext_vector_type(16)));
typedef float f32x4 __attribute__((ext_vector_type(4)));
typedef unsigned u32x4 __attribute__((ext_vector_type(4)));
constexpr int D = 128, NW = 8, QBLK = 32, KVBLK = 64, QB = NW * QBLK;
constexpr int SHM_V = KVBLK * D * 2, SHM_K = KVBLK * D * 2;
constexpr int LDS_BYTES = 2 * SHM_V + 2 * SHM_K + NW * 64 * 4;
constexpr float SCALE = 0.08838834764831845f;
constexpr float THR = 8.f;
constexpr int PQ = 5888;
constexpr int PO = 2048;
constexpr int MSTRIDE = 4096;

#define KSWZ(row, colB) ((row) * 256 + ((colB) ^ (((row) & 7) << 4)))
#define SBAR() __builtin_amdgcn_sched_barrier(0)
__device__ __forceinline__ int v_st(int k, int c) { const int kk = (k & ~0xC) | ((k & 4) << 1) | ((k & 8) >> 1); return ((kk >> 3) * 4 + (c >> 5)) * 512 + ((kk & 7) * 32 + (c & 31)) * 2; }
__device__ __forceinline__ int v_rd_base(int lane) { return ((lane & 3) << 3) | (((lane >> 2) & 3) << 6) | (((lane >> 4) & 1) << 5) | (((lane >> 5) & 1) << 8); }
constexpr int v_rd_off(int d0, int ks, int half) { return d0 * 512 + ks * 4096 + half * 2048; }
__device__ __forceinline__ int crow(int r, int hi) { return (r & 3) + 8 * (r >> 2) + 4 * hi; }
__device__ __forceinline__ unsigned cvtpk(float lo, float hi) { unsigned r; asm volatile("v_cvt_pk_bf16_f32 %0, %1, %2" : "=v"(r) : "v"(lo), "v"(hi)); return r; }
#define LOAD8(rs, voff, soff) __builtin_bit_cast(bf16x8, __builtin_amdgcn_raw_buffer_load_b128((rs), (int)(voff), (int)(soff), 0))
__device__ __forceinline__ void mask_bits(f32x16& p0, f32x16& p1, unsigned long long mw, int hi) {
    const float NEG = -__builtin_inff();
    const unsigned w0 = ((unsigned)mw) >> (4 * hi), w1 = ((unsigned)(mw >> 32)) >> (4 * hi);
#pragma unroll
    for (int r = 0; r < 16; ++r) {
        const int c = (r & 3) + 8 * (r >> 2);
        if (!((w0 >> c) & 1u)) p0[r] = NEG;
        if (!((w1 >> c) & 1u)) p1[r] = NEG;
    }
}
__device__ __forceinline__ void partialSM(f32x16& p0, f32x16& p1, float& m_reg, float& mn, float& alpha) {
    float pmax = p0[0];
#pragma unroll
    for (int r = 1; r < 16; ++r) pmax = fmaxf(pmax, p0[r]);
#pragma unroll
    for (int r = 0; r < 16; ++r) pmax = fmaxf(pmax, p1[r]);
    { auto rr = __builtin_amdgcn_permlane32_swap(__float_as_uint(pmax), __float_as_uint(pmax), false, false);
      pmax = fmaxf(__uint_as_float(rr[0]), __uint_as_float(rr[1])); }
    constexpr float C2 = 1.4426950408889634f * SCALE;
    if (__builtin_expect(__all((pmax - m_reg) * SCALE <= THR), 1)) { mn = m_reg; alpha = 1.f; }
    else { mn = fmaxf(m_reg, pmax); alpha = __builtin_amdgcn_exp2f((m_reg - mn) * C2); m_reg = mn; }
    const float mnL = -mn * C2;
#pragma unroll
    for (int r = 0; r < 16; ++r) p0[r] = fmaf(p0[r], C2, mnL);
#pragma unroll
    for (int r = 0; r < 16; ++r) p1[r] = fmaf(p1[r], C2, mnL);
#pragma unroll
    for (int r = 0; r < 16; ++r) p0[r] = __builtin_amdgcn_exp2f(p0[r]);
}
__device__ __forceinline__ void finishSM(f32x16& p0, f32x16& p1, float alpha, float& l_reg, bf16x8& pa0, bf16x8& pa1, bf16x8& pa2, bf16x8& pa3) {
#pragma unroll
    for (int r = 0; r < 16; ++r) p1[r] = __builtin_amdgcn_exp2f(p1[r]);
    float ps = 0;
#pragma unroll
    for (int r = 0; r < 16; ++r) ps += p0[r];
#pragma unroll
    for (int r = 0; r < 16; ++r) ps += p1[r];
    { auto rr = __builtin_amdgcn_permlane32_swap(__float_as_uint(ps), __float_as_uint(ps), false, false);
      ps = __uint_as_float(rr[0]) + __uint_as_float(rr[1]); }
    l_reg = l_reg * alpha + ps;
#define PK4(P, B_, OUT) do { unsigned a0 = cvtpk(P[B_+0], P[B_+1]), a1 = cvtpk(P[B_+2], P[B_+3]);                          \
        unsigned b0 = cvtpk(P[B_+4], P[B_+5]), b1 = cvtpk(P[B_+6], P[B_+7]);                                             \
        auto r0 = __builtin_amdgcn_permlane32_swap(a0, b0, false, false); auto r1 = __builtin_amdgcn_permlane32_swap(a1, b1, false, false); \
        u32x4 w = {r0[0], r1[0], r0[1], r1[1]}; OUT = *reinterpret_cast<bf16x8*>(&w); } while (0)
    PK4(p0, 0, pa0); PK4(p0, 8, pa1); PK4(p1, 0, pa2); PK4(p1, 8, pa3);
#undef PK4
}
template <int KB>
__device__ __forceinline__ void qkt(f32x16& p0, f32x16& p1, const char* K_lds, int r32, int hi, const bf16x8* qr) {
    p0 = f32x16{}; p1 = f32x16{};
    const char* kb[4];
#pragma unroll
    for (int dd = 0; dd < 4; ++dd) kb[dd] = K_lds + KB * SHM_K + KSWZ(r32, (dd * 16 + hi * 8) * 2);
#pragma unroll
    for (int d0 = 0; d0 < 8; ++d0) { const char* a = kb[d0 & 3] + (d0 >> 2) * 128;
        bf16x8 b0 = *reinterpret_cast<const bf16x8*>(a);
        bf16x8 b1 = *reinterpret_cast<const bf16x8*>(a + 32 * 256);
        p0 = __builtin_amdgcn_mfma_f32_32x32x16_bf16(b0, qr[d0], p0, 0, 0, 0);
        p1 = __builtin_amdgcn_mfma_f32_32x32x16_bf16(b1, qr[d0], p1, 0, 0, 0); }
}
template <int VB>
__device__ __forceinline__ void pv_tile(f32x16* o, int vb0, bf16x8 pa0, bf16x8 pa1, bf16x8 pa2, bf16x8 pa3) {
#define TRRD(dst, off) asm volatile("ds_read_b64_tr_b16 %0, %1 offset:%2" : "=&v"(dst) : "v"(vb0), "i"(off) : "memory")
#define PV_D0(d0) do { s16x4 l0, l1, l2, l3, h0, h1, h2, h3; constexpr int b_ = VB * SHM_V + v_rd_off(d0, 0, 0);   \
        TRRD(l0, b_); TRRD(h0, b_ + 2048); TRRD(l1, b_ + 4096); TRRD(h1, b_ + 6144); TRRD(l2, b_ + 8192); TRRD(h2, b_ + 10240); TRRD(l3, b_ + 12288); TRRD(h3, b_ + 14336); \
        asm volatile("s_waitcnt lgkmcnt(0)" ::: "memory"); SBAR();   \
        o[d0] = __builtin_amdgcn_mfma_f32_32x32x16_bf16(pa0, (bf16x8){l0[0], l0[1], l0[2], l0[3], h0[0], h0[1], h0[2], h0[3]}, o[d0], 0, 0, 0);   \
        o[d0] = __builtin_amdgcn_mfma_f32_32x32x16_bf16(pa1, (bf16x8){l1[0], l1[1], l1[2], l1[3], h1[0], h1[1], h1[2], h1[3]}, o[d0], 0, 0, 0);   \
        o[d0] = __builtin_amdgcn_mfma_f32_32x32x16_bf16(pa2, (bf16x8){l2[0], l2[1], l2[2], l2[3], h2[0], h2[1], h2[2], h2[3]}, o[d0], 0, 0, 0);   \
        o[d0] = __builtin_amdgcn_mfma_f32_32x32x16_bf16(pa3, (bf16x8){l3[0], l3[1], l3[2], l3[3], h3[0], h3[1], h3[2], h3[3]}, o[d0], 0, 0, 0); } while (0)
    PV_D0(0); PV_D0(1); PV_D0(2); PV_D0(3);
#undef PV_D0
#undef TRRD
}

struct BlockRef { unsigned qo, ko, vo, oo, mo; int P0; };
struct Res { __amdgpu_buffer_rsrc_t z, mix, mk; };
typedef unsigned ru4 __attribute__((__vector_size__(16)));
typedef unsigned ru2 __attribute__((__vector_size__(8)));
struct Seam { bf16x8 qr[8]; bf16x8 st_v0, st_v1, st_k0, st_k1; };
#define VMW() asm volatile("s_waitcnt vmcnt(0)" ::: "memory")
#define VMWN(n) asm volatile("s_waitcnt vmcnt(%0)" :: "i"(n) : "memory")
#define SLOAD_H(Kp, Vp, k0) do { const unsigned vp_ = (Vp) + (unsigned)(k0) * (PQ * 2), kp_ = (Kp) + (unsigned)(k0) * (PQ * 2);                  \
                         S.st_v0 = LOAD8(R.z, kvoff, vp_); S.st_v1 = LOAD8(R.z, kvoff, vp_ + 32 * PQ * 2);              \
                         S.st_k0 = LOAD8(R.z, kvoff, kp_); S.st_k1 = LOAD8(R.z, kvoff, kp_ + 32 * PQ * 2); } while (0)
#define SWRITE_HK(bf) do { *(bf16x8*)(K_lds + (bf) * SHM_K + kws) = S.st_k0; *(bf16x8*)(K_lds + (bf) * SHM_K + kws + 32 * 256) = S.st_k1; } while (0)
#define SWRITE_HV(bf) do { *(bf16x8*)(V_lds + (bf) * SHM_V + vst0) = S.st_v0; *(bf16x8*)(V_lds + (bf) * SHM_V + vst1) = S.st_v1; } while (0)
#define SWRITE_H(bf) do { SWRITE_HV(bf); SWRITE_HK(bf); } while (0)
__device__ __forceinline__ void prime(const Res& R, const BlockRef& cur, char* lds, Seam& S) {
    int tid_ = threadIdx.x; asm volatile("" : "+v"(tid_)); const int tid = tid_, wid = __builtin_amdgcn_readfirstlane(tid >> 6), lane = tid & 63, r32 = lane & 31, hi = lane >> 5;
    const int sr = tid >> 4, sc = (tid & 15) * 8, kws = KSWZ(sr, sc * 2); char* K_lds = lds + 2 * SHM_V;
    const unsigned kvoff = (unsigned)(sr * PQ + sc) * 2u, qoff = (unsigned)(r32 * PQ + hi * 8) * 2u;
    { const unsigned qb_ = cur.qo + (unsigned)(wid * QBLK) * (PQ * 2);
#pragma unroll
    for (int d0 = 0; d0 < 8; ++d0) S.qr[d0] = LOAD8(R.z, qoff, qb_ + d0 * 32); }
    SLOAD_H(cur.ko, cur.vo, 0); VMW(); SWRITE_HK(0);
    __syncthreads();
}
__device__ __forceinline__ void block(const Res& R, const BlockRef& cur, const BlockRef& nxt, char* lds, Seam& S) {
    int tid_ = threadIdx.x; asm volatile("" : "+v"(tid_)); const int tid = tid_, wid = __builtin_amdgcn_readfirstlane(tid >> 6), lane = tid & 63, r32 = lane & 31, hi = lane >> 5;
    const int NT = cur.P0 / KVBLK + QB / KVBLK;
    char* V_lds = lds; char* K_lds = lds + 2 * SHM_V;
    float* ws = (float*)(lds + 2 * SHM_V + 2 * SHM_K) + wid * 64; float* li_l = ws, * al_l = ws + 32;
    float m_reg = -1e30f, l_reg = 0; f32x16 o[4] = {};
    const int sr = tid >> 4, sc = (tid & 15) * 8, vst0 = v_st(sr, sc), vst1 = v_st(32 + sr, sc), kws = KSWZ(sr, sc * 2);
    const int vb0 = (int)(uintptr_t)V_lds + v_rd_base(lane);
    const unsigned Kh = cur.ko, Vh = cur.vo;
    const unsigned kvoff = (unsigned)(sr * PQ + sc) * 2u, qoff = (unsigned)(r32 * PQ + hi * 8) * 2u, mkoff = (unsigned)r32 * 8u;
    const unsigned mk = cur.mo + (unsigned)(wid * QBLK) * 8u;
#define MKW(t) __builtin_bit_cast(unsigned long long, __builtin_amdgcn_raw_buffer_load_b64(R.mk, (int)mkoff, (int)(mk + (unsigned)(t) * (MSTRIDE * 8)), 0))
#define RESC(a) do { if (__any((a) < 1.f)) { if (hi == 0) al_l[r32] = (a); asm volatile("s_waitcnt lgkmcnt(0)" ::: "memory");              \
                     for (int d_ = 0; d_ < 4; ++d_) for (int r = 0; r < 16; ++r) o[d_][r] *= al_l[crow(r, hi)]; } } while (0)
#define KBASE(t) ((t) * KVBLK)
    constexpr int NQL = 8;
#define SEAM_K0() do { VMWN(NQL); SWRITE_HK(0); SBAR(); } while (0)
    f32x16 pA0, pA1, pB0, pB1; float mnA, mnB, alA, alB; bf16x8 pa0, pa1, pa2, pa3;
    SWRITE_HV(0); SBAR();
    if (NT > 1) { SLOAD_H(Kh, Vh, KBASE(1)); }
    const unsigned long long mw0 = MKW(0);
    SBAR(); qkt<0>(pA0, pA1, K_lds, r32, hi, S.qr);
    mask_bits(pA0, pA1, mw0, hi); partialSM(pA0, pA1, m_reg, mnA, alA);
    if (NT > 1) { VMW(); SWRITE_H(1); }
    __syncthreads();
#define HALF_STEP(PX0, PX1, mnX, alX, PY0, PY1, alY, t, KB, VB, SB) do {                                                      \
        const unsigned long long mw_ = MKW(t);                                                             \
        SBAR(); qkt<KB>(PX0, PX1, K_lds, r32, hi, S.qr);                                                                      \
        finishSM(PY0, PY1, alY, l_reg, pa0, pa1, pa2, pa3); SBAR();                                                           \
        if ((t) + 1 < NT) { SLOAD_H(Kh, Vh, KBASE((t) + 1)); SBAR(); }                                                        \
        pv_tile<VB>(o, vb0, pa0, pa1, pa2, pa3); mask_bits(PX0, PX1, mw_, hi); partialSM(PX0, PX1, m_reg, mnX, alX);          \
        __syncthreads();                                                                                                      \
        if ((t) + 1 < NT) { VMW(); SWRITE_H(SB); }                                                                            \
        RESC(alX); __syncthreads(); } while (0)
    for (int t = 1; t + 1 < NT; t += 2) {
        HALF_STEP(pB0, pB1, mnB, alB, pA0, pA1, alA, t, 1, 0, 0);
        HALF_STEP(pA0, pA1, mnA, alA, pB0, pB1, alB, t + 1, 0, 1, 1);
    }
    const bool even = (NT & 1) == 0;
    unsigned long long mwl = 0ull;
    if (even) { mwl = MKW(NT - 1); SBAR(); qkt<1>(pB0, pB1, K_lds, r32, hi, S.qr); SBAR(); }
    SLOAD_H(nxt.ko, nxt.vo, 0); SBAR();
    { const unsigned qb_ = nxt.qo + (unsigned)(wid * QBLK) * (PQ * 2);
#pragma unroll
    for (int d0 = 0; d0 < 8; ++d0) S.qr[d0] = LOAD8(R.z, qoff, qb_ + d0 * 32); }
    SBAR();
    finishSM(pA0, pA1, alA, l_reg, pa0, pa1, pa2, pa3); SBAR();
    pv_tile<0>(o, vb0, pa0, pa1, pa2, pa3);
    if (even) { mask_bits(pB0, pB1, mwl, hi); partialSM(pB0, pB1, m_reg, mnB, alB); __syncthreads(); RESC(alB);
        finishSM(pB0, pB1, alB, l_reg, pa0, pa1, pa2, pa3); SBAR(); pv_tile<1>(o, vb0, pa0, pa1, pa2, pa3); }
    SBAR(); SEAM_K0();
    if (hi == 0) li_l[r32] = l_reg; asm volatile("s_waitcnt lgkmcnt(0)" ::: "memory");
    float rli[16];
#pragma unroll
    for (int r = 0; r < 16; ++r) rli[r] = __builtin_amdgcn_rcpf(li_l[crow(r, hi)]);
    const unsigned Ow = cur.oo + (unsigned)(wid * QBLK) * (PO * 2);
    const unsigned ooff = (unsigned)(4 * hi * PO + r32) * 2u;
#pragma unroll
    for (int r = 0; r < 16; ++r) { const int orow0 = (r & 3) + 8 * (r >> 2);
#pragma unroll
        for (int d0 = 0; d0 < 4; ++d0) { const float v = o[d0][r] * rli[r];
            const float vn = __shfl_xor(v, 1);
            if ((r32 & 1) == 0) __builtin_amdgcn_raw_buffer_store_b32(cvtpk(v, vn), R.mix, (int)ooff, (int)(Ow + (orow0 * PO + d0 * 32) * 2), 0); } }
    __syncthreads();
#undef RESC
#undef MKW
#undef KBASE
#undef SEAM_K0
#undef HALF_STEP
}
#undef ROW
#undef VMW
#undef VMWN
#undef SLOAD_H
#undef SWRITE_HK
#undef SWRITE_HV
#undef SWRITE_H
#undef KSWZ
#undef SBAR
#undef LOAD8
}

constexpr int NWAVES = 8;
constexpr int BATCH = 2, SEQ = 4096, DM = 2048, DEPTH = 4, M = BATCH * SEQ;
constexpr int HD = 128, D_POOL = 512, D_ATTN = 1024, NH = 8, NIH = 16, DIDX = 64, TOPK = 256, D_GMLP = 512, CHUNK = 128;
constexpr int D_IN = 5712, ZP = 5888, D_FF = 5632, D_UP = 2 * D_FF;
constexpr float EPS = 1e-6f;
constexpr int ZC_POOL = 0, ZC_Q = 512, ZC_K = 1536, ZC_V = 2560, ZC_QI = 3584, ZC_KI = 4608, ZC_WI = 4672, ZC_PAD = 4688, ZC_G = 4864;
constexpr int GELU_PN0 = ZC_G / 256;
static_assert(ZC_G % 256 == 0 && ZC_G + 2 * D_GMLP == ZP && ZP % 256 == 0 && att::PQ == ZP && att::PO == DM && att::MSTRIDE == SEQ, "Z layout");

constexpr size_t MiB = 1u << 20;
constexpr size_t SZ_WIN = (size_t)ZP * DM * 2, SZ_WOUT = (size_t)DM * DM * 2, SZ_WUP = (size_t)D_UP * DM * 2, SZ_WDN = (size_t)DM * D_FF * 2;
constexpr size_t WS_CTL = 0, CTL_ZERO_BYTES = 1 * MiB;
constexpr size_t WS_WIN = 1 * MiB;
constexpr size_t WS_WOUT = WS_WIN + DEPTH * SZ_WIN;
constexpr size_t WS_WUP = WS_WOUT + DEPTH * SZ_WOUT;
constexpr size_t WS_WDN = WS_WUP + DEPTH * SZ_WUP;
constexpr size_t WS_XB = WS_WDN + DEPTH * SZ_WDN;
constexpr size_t WS_Z = WS_XB + (size_t)M * DM * 2;
constexpr size_t WS_MIX = WS_Z + (size_t)M * ZP * 2;
constexpr size_t WS_SC = WS_MIX + (size_t)M * DM * 2;
constexpr size_t WS_MASK = WS_SC + (size_t)M * SEQ * 4;
constexpr size_t WS_F32 = WS_MASK + (size_t)BATCH * 64 * SEQ * 8;
constexpr size_t WS_UP = WS_F32 + (size_t)M * DM * 4;
constexpr size_t WS_G = WS_UP + (size_t)M * D_UP * 2;
constexpr size_t WS_RS = WS_G + (size_t)M * D_FF * 2;
constexpr size_t WS_END = WS_RS + 1 * MiB;
static_assert(WS_WIN % 256 == 0 && WS_Z % 256 == 0 && WS_SC % 256 == 0 && WS_UP % 256 == 0 && WS_RS % 256 == 0, "alignment");
constexpr int CW_BAR = 4096;

constexpr int LDS_BYTES = 147456;
constexpr int LDSCTL_OFF = LDS_BYTES - 1024;
constexpr int SCRATCH_BYTES = LDSCTL_OFF;

#define GAS __attribute__((address_space(1)))
#define LAS __attribute__((address_space(3)))
typedef unsigned short bf16;
typedef unsigned v4u __attribute__((ext_vector_type(4)));
typedef unsigned v2u __attribute__((ext_vector_type(2)));
typedef float f32x4 __attribute__((ext_vector_type(4)));
typedef float f32x16 __attribute__((ext_vector_type(16)));
typedef short bf16x8 __attribute__((ext_vector_type(8)));
typedef GAS unsigned gu32;
#define RLX_AGENT __ATOMIC_RELAXED, __HIP_MEMORY_SCOPE_AGENT
#define LDS_WAIT() asm volatile("s_waitcnt lgkmcnt(0)" ::: "memory")
#define VM_WAIT() asm volatile("s_waitcnt vmcnt(0)" ::: "memory")
__device__ __forceinline__ unsigned pk2(float lo, float hi) { unsigned r; asm volatile("v_cvt_pk_bf16_f32 %0, %1, %2" : "=v"(r) : "v"(lo), "v"(hi)); return r; }
__device__ __forceinline__ float bflo(unsigned w) { return __uint_as_float(w << 16); }
__device__ __forceinline__ float bfhi(unsigned w) { return __uint_as_float(w & 0xffff0000u); }
__device__ __forceinline__ float wave_sum(float v) {
#pragma unroll
    for (int o = 1; o < 64; o <<= 1) v += __shfl_xor(v, o);
    return v;
}
#define XB_TMO      128
#define XB_XCNT(j)  (256  + 64 * (j))
#define XB_XSUB(j)  (1280 + 64 * (j))
#define XB_XGEN(j)  (2304 + 64 * (j))
#define XB_TOP      3328
#define XB_TOPGEN   3392
#define XCD_BAR_WORDS 3456
#define XB_SPIN_CAP (1u << 18)

__device__ __forceinline__ unsigned xb_ld(unsigned* p)              { return __hip_atomic_load(p, __ATOMIC_RELAXED, __HIP_MEMORY_SCOPE_AGENT); }
__device__ __forceinline__ unsigned xb_add(unsigned* p, unsigned v) { return __hip_atomic_fetch_add(p, v, __ATOMIC_RELAXED, __HIP_MEMORY_SCOPE_AGENT); }
__device__ __forceinline__ unsigned xb_xcc_id() { return (unsigned)__builtin_amdgcn_s_getreg((3 << 11) | 20) & 0xFu; }
#define XB_SPIN(cond, bar) do { unsigned _sp = 0; while (cond) { __builtin_amdgcn_s_sleep(1); \
    if ((++_sp & 255u) == 0u) { if (xb_ld(&(bar)[XB_TMO])) break; if (_sp > XB_SPIN_CAP) { atomicAdd(&(bar)[XB_TMO], 1u); break; } } } } while (0)

struct XcdBarrier {
    unsigned* bar; unsigned x;
    volatile LAS unsigned* st;
};

__device__ __forceinline__ XcdBarrier xcd_barrier_post(unsigned* bar, volatile LAS unsigned* st) {
    XcdBarrier b; b.bar = bar; b.x = xb_xcc_id(); b.st = st;
    if (threadIdx.x == 0) (void)xb_add(&bar[XB_XCNT(b.x)], 1u);
    return b;
}
__device__ __forceinline__ void xcd_barrier_complete(unsigned* bar, unsigned x, unsigned& nloc, unsigned& nx) {
    const unsigned G = gridDim.x * gridDim.y * gridDim.z;
    unsigned sum, cnt, mine, sp = 0u;
    for (;;) {
        sum = 0u; cnt = 0u; mine = 0u;
#pragma unroll
        for (unsigned j = 0; j < 16; ++j) { const unsigned c = xb_ld(&bar[XB_XCNT(j)]); sum += c; cnt += (c > 0u) ? 1u : 0u; mine = (j == x) ? c : mine; }
        if (sum == G) break;
        __builtin_amdgcn_s_sleep(1);
        if ((++sp & 255u) == 0u) { if (xb_ld(&bar[XB_TMO])) break; if (sp > XB_SPIN_CAP) { atomicAdd(&bar[XB_TMO], 1u); break; } }
    }
    nloc = mine > 0u ? mine : 1u; nx = cnt > 0u ? cnt : 1u;
}

__device__ __forceinline__ void xcd_barrier(const XcdBarrier& b) {
    asm volatile("s_waitcnt vmcnt(0)" ::: "memory");
    __syncthreads();
    if (threadIdx.x == 0) {
        unsigned* bar = b.bar;
        __builtin_amdgcn_s_waitcnt(0);
        unsigned nloc = b.st[0], nx = b.st[1];
        if (nloc == 0u) { xcd_barrier_complete(bar, b.x, nloc, nx); b.st[0] = nloc; b.st[1] = nx; }
        const unsigned old = xb_add(&bar[XB_XSUB(b.x)], 1u);
        const unsigned gen = old / nloc;
        if (old + 1u == (gen + 1u) * nloc) {
            __builtin_amdgcn_fence(__ATOMIC_RELEASE, "agent");
            asm volatile("s_waitcnt vmcnt(0)" ::: "memory");
            const unsigned og = xb_add(&bar[XB_TOP], 1u);
            const unsigned tg = og / nx;
            if (og + 1u == (tg + 1u) * nx) xb_add(&bar[XB_TOPGEN], 1u);
            else XB_SPIN(xb_ld(&bar[XB_TOPGEN]) == tg, bar);
            __builtin_amdgcn_fence(__ATOMIC_ACQUIRE, "agent");
            xb_add(&bar[XB_XGEN(b.x)], 1u);
            asm volatile("s_waitcnt vmcnt(0)" ::: "memory");
        } else {
            XB_SPIN(xb_ld(&bar[XB_XGEN(b.x)]) == gen, bar);
            __builtin_amdgcn_fence(__ATOMIC_ACQUIRE, "agent");
            asm volatile("s_waitcnt vmcnt(0)" ::: "memory");
        }
    }
    __syncthreads();
}

struct Frame {
    LAS unsigned char* lds;
    volatile LAS unsigned* MISC;
    gu32* ctl;
    int tid, lane, wave, vcu, G;
    float* out; unsigned char* ws;
};
struct Args { const float* in[17]; float* out; unsigned char* ws; int ph_lo, ph_hi; };
static_assert(sizeof(Args) == 17 * 8 + 8 + 8 + 8, "Args has no padding");
__device__ __forceinline__ void refresh(Frame& F) { int t = threadIdx.x; asm volatile("" : "+v"(t)); F.tid = t; F.lane = t & 63; F.wave = __builtin_amdgcn_readfirstlane(t >> 6); }
enum { IN_X = 0, IN_WIN, IN_POOLW, IN_POOLS, IN_LNG, IN_LNB, IN_SGUW, IN_SGUB, IN_WOUT, IN_WUP, IN_CONVW, IN_CONVB, IN_WDN, IN_NPM, IN_NQM, IN_NPF, IN_NQF };

__device__ __forceinline__ void p0_transpose_item(const float* W, int K, int Nsrc, const float* gain, bf16* WT, int mode, LAS float* scr, int item, int nblk, int lane) {
    const int kb = item / nblk, nb = item - kb * nblk, k0 = 64 * kb, n0 = 64 * nb;
    const int kq = lane >> 4, nd = n0 + (lane & 15) * 4;
    int ns = nd;
    if (mode == 1) ns = nd < ZC_PAD ? nd : (nd < ZC_G ? -1 : nd - (ZC_G - ZC_PAD));
    f32x4 v[16];
    const float* src = W + (size_t)(k0 + kq) * Nsrc + (ns >= 0 ? ns : 0);
#pragma unroll
    for (int i = 0; i < 16; ++i) v[i] = (ns >= 0) ? __builtin_nontemporal_load((const GAS f32x4*)(src + (size_t)(4 * i) * Nsrc)) : (f32x4){0.f, 0.f, 0.f, 0.f};
    if (gain) {
#pragma unroll
        for (int i = 0; i < 16; ++i) v[i] = v[i] * gain[k0 + 4 * i + kq];
    }
    LAS float* wp = scr + kq * 65 + (lane & 15) * 4;
#pragma unroll
    for (int i = 0; i < 16; ++i) { wp[(4 * i) * 65 + 0] = v[i].x; wp[(4 * i) * 65 + 1] = v[i].y; wp[(4 * i) * 65 + 2] = v[i].z; wp[(4 * i) * 65 + 3] = v[i].w; }
    LDS_WAIT(); asm volatile("" ::: "memory");
    const int c = lane & 7;
#pragma unroll
    for (int j = 0; j < 8; ++j) { const int n = (lane >> 3) + 8 * j; const LAS float* s = scr + (8 * c) * 65 + n;
        v4u o; o.x = pk2(s[0 * 65], s[1 * 65]); o.y = pk2(s[2 * 65], s[3 * 65]); o.z = pk2(s[4 * 65], s[5 * 65]); o.w = pk2(s[6 * 65], s[7 * 65]);
        *(GAS v4u*)(WT + (size_t)(n0 + n) * K + k0 + 8 * c) = o; }
    LDS_WAIT(); asm volatile("" ::: "memory");
}
__device__ __forceinline__ void p0_weights(Frame& F, const Args& A) {
    LAS float* scr = (LAS float*)(F.lds + F.wave * 16640);
    const int gw = F.vcu * NWAVES + F.wave, NGW = F.G * NWAVES;
    constexpr int I_IN = (DM / 64) * (ZP / 64), I_OUT = (DM / 64) * (DM / 64), I_UP = (DM / 64) * (D_UP / 64), I_DN = (D_FF / 64) * (DM / 64);
    constexpr int I_LAYER = I_IN + I_OUT + I_UP + I_DN;
    for (int it = gw; it < DEPTH * I_LAYER; it += NGW) {
        const int l = it / I_LAYER; int r = it - l * I_LAYER;
        if (r < I_IN) { p0_transpose_item(A.in[IN_WIN] + (size_t)l * DM * D_IN, DM, D_IN, A.in[IN_NPM] + l * DM, (bf16*)(F.ws + WS_WIN + l * SZ_WIN), 1, scr, r, ZP / 64, F.lane); continue; } r -= I_IN;
        if (r < I_OUT) { p0_transpose_item(A.in[IN_WOUT] + (size_t)l * DM * DM, DM, DM, nullptr, (bf16*)(F.ws + WS_WOUT + l * SZ_WOUT), 0, scr, r, DM / 64, F.lane); continue; } r -= I_OUT;
        if (r < I_UP) { p0_transpose_item(A.in[IN_WUP] + (size_t)l * DM * D_UP, DM, D_UP, A.in[IN_NPF] + l * DM, (bf16*)(F.ws + WS_WUP + l * SZ_WUP), 0, scr, r, D_UP / 64, F.lane); continue; } r -= I_UP;
        p0_transpose_item(A.in[IN_WDN] + (size_t)l * D_FF * DM, D_FF, DM, nullptr, (bf16*)(F.ws + WS_WDN + l * SZ_WDN), 0, scr, r, DM / 64, F.lane);
    }
}
__device__ __forceinline__ void p0_rows(Frame& F, const Args& A) {
    const int gw = F.vcu * NWAVES + F.wave, NGW = F.G * NWAVES;
    const float* x = A.in[IN_X]; bf16* xb = (bf16*)(F.ws + WS_XB); float* RS = (float*)(F.ws + WS_RS);
    for (int m = gw; m < M; m += NGW) {
        const GAS f32x4* xr = (const GAS f32x4*)(x + (size_t)m * DM) + F.lane;
        f32x4 v[8]; float s = 0.f;
#pragma unroll
        for (int j = 0; j < 8; ++j) { v[j] = xr[64 * j]; s += (v[j].x * v[j].x + v[j].y * v[j].y) + (v[j].z * v[j].z + v[j].w * v[j].w); }
        s = wave_sum(s);
        if (F.lane == 0) RS[m] = 1.0f / sqrtf(s * (1.f / DM) + EPS);
        GAS v2u* o8 = (GAS v2u*)(xb + (size_t)m * DM) + F.lane;
#pragma unroll
        for (int j = 0; j < 8; ++j) { v2u w; w.x = pk2(v[j].x, v[j].y); w.y = pk2(v[j].z, v[j].w); o8[64 * j] = w; }
    }
}
__device__ __forceinline__ void thin_phase(Frame& F, const float* y, const float* xin, float* xout, const float* g) {
    const int gw = F.vcu * NWAVES + F.wave, NGW = F.G * NWAVES;
    bf16* xb = (bf16*)(F.ws + WS_XB); float* RS = (float*)(F.ws + WS_RS);
    for (int m = gw; m < M; m += NGW) {
        const GAS f32x4* yr = (const GAS f32x4*)(y + (size_t)m * DM) + F.lane;
        const GAS f32x4* xr = (const GAS f32x4*)(xin + (size_t)m * DM) + F.lane;
        const GAS f32x4* gr = (const GAS f32x4*)g + F.lane;
        f32x4 yv[8], xv[8]; float s = 0.f;
#pragma unroll
        for (int j = 0; j < 8; ++j) { yv[j] = yr[64 * j]; xv[j] = xr[64 * j]; }
#pragma unroll
        for (int j = 0; j < 8; ++j) s += (yv[j].x * yv[j].x + yv[j].y * yv[j].y) + (yv[j].z * yv[j].z + yv[j].w * yv[j].w);
        const float r = 1.0f / sqrtf(wave_sum(s) * (1.f / DM) + EPS);
        float s2 = 0.f;
#pragma unroll
        for (int j = 0; j < 8; ++j) { const f32x4 gg = gr[64 * j]; xv[j] = xv[j] + yv[j] * r * gg;
            s2 += (xv[j].x * xv[j].x + xv[j].y * xv[j].y) + (xv[j].z * xv[j].z + xv[j].w * xv[j].w); }
        s2 = wave_sum(s2);
        if (F.lane == 0) RS[m] = 1.0f / sqrtf(s2 * (1.f / DM) + EPS);
        GAS f32x4* xo = (GAS f32x4*)(xout + (size_t)m * DM) + F.lane;
        GAS v2u* o8 = (GAS v2u*)(xb + (size_t)m * DM) + F.lane;
#pragma unroll
        for (int j = 0; j < 8; ++j) { xo[64 * j] = xv[j]; v2u w; w.x = pk2(xv[j].x, xv[j].y); w.y = pk2(xv[j].z, xv[j].w); o8[64 * j] = w; }
    }
}
__device__ __forceinline__ void unpack8(const v4u r, float (&f)[8]) { f[0] = bflo(r.x); f[1] = bfhi(r.x); f[2] = bflo(r.y); f[3] = bfhi(r.y); f[4] = bflo(r.z); f[5] = bfhi(r.z); f[6] = bflo(r.w); f[7] = bfhi(r.w); }
__device__ __forceinline__ void conv_phase(Frame& F, const Args& A, int l) {
    const int gw = F.vcu * NWAVES + F.wave, NGW = F.G * NWAVES;
    const bf16* UP = (const bf16*)(F.ws + WS_UP); bf16* Gb = (bf16*)(F.ws + WS_G);
    const float* cw = A.in[IN_CONVW] + (size_t)l * 3 * D_UP; const float* cb = A.in[IN_CONVB] + (size_t)l * D_UP;
    constexpr int NCC = D_FF / 512, NRC = M / 16;
    for (int it = gw; it < NCC * NRC; it += NGW) {
        const int cc = it % NCC, rc = it / NCC, r0 = rc * 16, c0 = cc * 512 + F.lane * 8;
        float wg[3][8], wv[3][8], bg[8], bv[8];
#pragma unroll
        for (int j = 0; j < 3; ++j)
#pragma unroll
            for (int h = 0; h < 2; ++h) { const f32x4 a = *(const GAS f32x4*)(cw + (size_t)j * D_UP + c0 + 4 * h), b = *(const GAS f32x4*)(cw + (size_t)j * D_UP + D_FF + c0 + 4 * h);
                wg[j][4 * h] = a.x; wg[j][4 * h + 1] = a.y; wg[j][4 * h + 2] = a.z; wg[j][4 * h + 3] = a.w; wv[j][4 * h] = b.x; wv[j][4 * h + 1] = b.y; wv[j][4 * h + 2] = b.z; wv[j][4 * h + 3] = b.w; }
#pragma unroll
        for (int h = 0; h < 2; ++h) { const f32x4 a = *(const GAS f32x4*)(cb + c0 + 4 * h), b = *(const GAS f32x4*)(cb + D_FF + c0 + 4 * h);
            bg[4 * h] = a.x; bg[4 * h + 1] = a.y; bg[4 * h + 2] = a.z; bg[4 * h + 3] = a.w; bv[4 * h] = b.x; bv[4 * h + 1] = b.y; bv[4 * h + 2] = b.z; bv[4 * h + 3] = b.w; }
        float g2[8], g1[8], v2[8], v1[8];
        if ((r0 & (SEQ - 1)) == 0) {
#pragma unroll
            for (int k = 0; k < 8; ++k) { g2[k] = 0.f; g1[k] = 0.f; v2[k] = 0.f; v1[k] = 0.f; }
        } else {
            unpack8(*(const GAS v4u*)(UP + (size_t)(r0 - 2) * D_UP + c0), g2); unpack8(*(const GAS v4u*)(UP + (size_t)(r0 - 1) * D_UP + c0), g1);
            unpack8(*(const GAS v4u*)(UP + (size_t)(r0 - 2) * D_UP + D_FF + c0), v2); unpack8(*(const GAS v4u*)(UP + (size_t)(r0 - 1) * D_UP + D_FF + c0), v1);
        }
#pragma unroll 4
        for (int i = 0; i < 16; ++i) {
            float g0[8], v0[8], o[8];
            unpack8(*(const GAS v4u*)(UP + (size_t)(r0 + i) * D_UP + c0), g0); unpack8(*(const GAS v4u*)(UP + (size_t)(r0 + i) * D_UP + D_FF + c0), v0);
#pragma unroll
            for (int k = 0; k < 8; ++k) {
                const float cg = bg[k] + wg[0][k] * g2[k] + wg[1][k] * g1[k] + wg[2][k] * g0[k];
                const float cv = bv[k] + wv[0][k] * v2[k] + wv[1][k] * v1[k] + wv[2][k] * v0[k];
                const float sg = cg * __builtin_amdgcn_rcpf(1.0f + __builtin_amdgcn_exp2f(-1.4426950408889634f * cg));
                o[k] = sg * cv; g2[k] = g1[k]; g1[k] = g0[k]; v2[k] = v1[k]; v1[k] = v0[k]; }
            v4u w; w.x = pk2(o[0], o[1]); w.y = pk2(o[2], o[3]); w.z = pk2(o[4], o[5]); w.w = pk2(o[6], o[7]);
            *(GAS v4u*)(Gb + (size_t)(r0 + i) * D_FF + c0) = w;
        }
    }
}
__device__ __forceinline__ void pool_item(Frame& F, const Args& A, int l, int item) {
    const int g = item & 3, tt0 = (item >> 2) * 64, tid = F.tid;
    const bf16* Z = (const bf16*)(F.ws + WS_Z); bf16* MIX = (bf16*)(F.ws + WS_MIX);
    LAS float* Wl = (LAS float*)F.lds;
    LAS float* Pl = (LAS float*)(F.lds + 65536);
    const float* wp = A.in[IN_POOLW] + ((size_t)l * 4 + g) * 128 * 128;
#pragma unroll
    for (int i = 0; i < 8; ++i) { const int idx = (i * 512 + tid) * 4; *(LAS f32x4*)(Wl + idx) = *(const GAS f32x4*)(wp + idx); }
    {
        const int tt = tid >> 3, c16 = (tid & 7) * 16, row = tt0 + tt, t = row & (SEQ - 1), w = 2 << g;
        const int n = (t + 1) < w ? (t + 1) : w;
        float acc[16], cur[16];
        const bf16* p = Z + (size_t)row * ZP + ZC_POOL + g * 128 + c16;
        { float a[8], b[8]; unpack8(*(const GAS v4u*)p, a); unpack8(*(const GAS v4u*)(p + 8), b);
#pragma unroll
          for (int k = 0; k < 8; ++k) { cur[k] = a[k]; cur[8 + k] = b[k]; acc[k] = a[k]; acc[8 + k] = b[k]; } }
        for (int i = 1; i < n; ++i) { float a[8], b[8]; const bf16* q = p - (size_t)i * ZP; unpack8(*(const GAS v4u*)q, a); unpack8(*(const GAS v4u*)(q + 8), b);
#pragma unroll
            for (int k = 0; k < 8; ++k) { acc[k] += a[k]; acc[8 + k] += b[k]; } }
        const float inv = 1.0f / (float)n;
#pragma unroll
        for (int k4 = 0; k4 < 4; ++k4) { f32x4 o; o.x = acc[4 * k4] * inv - cur[4 * k4]; o.y = acc[4 * k4 + 1] * inv - cur[4 * k4 + 1]; o.z = acc[4 * k4 + 2] * inv - cur[4 * k4 + 2]; o.w = acc[4 * k4 + 3] * inv - cur[4 * k4 + 3];
            *(LAS f32x4*)(Pl + tt * 132 + c16 + 4 * k4) = o; }
    }
    __syncthreads();
    {
        const int tt = tid >> 3, dq = tid & 7, row = tt0 + tt;
        f32x4 y[4];
#pragma unroll
        for (int i = 0; i < 4; ++i) y[i] = (f32x4){0.f, 0.f, 0.f, 0.f};
        for (int c4 = 0; c4 < 32; ++c4) {
            const f32x4 p4 = *(const LAS f32x4*)(Pl + tt * 132 + 4 * c4);
#pragma unroll
            for (int cc = 0; cc < 4; ++cc) { const float pv = p4[cc];
#pragma unroll
                for (int i = 0; i < 4; ++i) { const f32x4 w4 = *(const LAS f32x4*)(Wl + (4 * c4 + cc) * 128 + dq * 16 + 4 * i); y[i] = y[i] + w4 * pv; } }
        }
        const float* ps = A.in[IN_POOLS] + (size_t)l * D_POOL + g * 128 + dq * 16;
#pragma unroll
        for (int i = 0; i < 4; ++i) y[i] = y[i] * *(const GAS f32x4*)(ps + 4 * i);
        v4u w0, w1; w0.x = pk2(y[0].x, y[0].y); w0.y = pk2(y[0].z, y[0].w); w0.z = pk2(y[1].x, y[1].y); w0.w = pk2(y[1].z, y[1].w);
        w1.x = pk2(y[2].x, y[2].y); w1.y = pk2(y[2].z, y[2].w); w1.z = pk2(y[3].x, y[3].y); w1.w = pk2(y[3].z, y[3].w);
        bf16* o = MIX + (size_t)row * DM + g * 128 + dq * 16;
        *(GAS v4u*)o = w0; *(GAS v4u*)(o + 8) = w1;
    }
    __syncthreads();
}
__device__ __forceinline__ void gmlp_item(Frame& F, const Args& A, int l, int item) {
    const int g = item & 3, row0 = (item >> 2) * 128, tid = F.tid, lane = F.lane;
    const bf16* Z = (const bf16*)(F.ws + WS_Z); bf16* MIX = (bf16*)(F.ws + WS_MIX);
    LAS float* Vl = (LAS float*)F.lds;
    LAS float* Wl = (LAS float*)(F.lds + 65536);
    const float* wsrc = A.in[IN_SGUW] + ((size_t)l * 4 + g) * 128 * 128;
    { const int t = tid >> 2, s0 = (tid & 3) * 32;
#pragma unroll
      for (int i = 0; i < 8; ++i) { f32x4 w = *(const GAS f32x4*)(wsrc + t * 128 + s0 + 4 * i); const int s = s0 + 4 * i;
          w.x = (s <= t) ? w.x : 0.f; w.y = (s + 1 <= t) ? w.y : 0.f; w.z = (s + 2 <= t) ? w.z : 0.f; w.w = (s + 3 <= t) ? w.w : 0.f;
          *(LAS f32x4*)(Wl + t * 132 + s) = w; } }
    { const float* lg = A.in[IN_LNG] + (size_t)l * D_GMLP + lane * 8; const float* lb = A.in[IN_LNB] + (size_t)l * D_GMLP + lane * 8;
      const f32x4 g0 = *(const GAS f32x4*)lg, g1 = *(const GAS f32x4*)(lg + 4), b0 = *(const GAS f32x4*)lb, b1 = *(const GAS f32x4*)(lb + 4);
      for (int j = 0; j < 16; ++j) { const int s = F.wave * 16 + j, row = row0 + s;
          float x[8]; unpack8(*(const GAS v4u*)(Z + (size_t)row * ZP + ZC_G + D_GMLP + lane * 8), x);
          float sm = 0.f;
#pragma unroll
          for (int k = 0; k < 8; ++k) sm += x[k];
          const float mu = wave_sum(sm) * (1.f / D_GMLP); float q = 0.f;
#pragma unroll
          for (int k = 0; k < 8; ++k) { x[k] -= mu; q += x[k] * x[k]; }
          const float rstd = 1.0f / sqrtf(wave_sum(q) * (1.f / D_GMLP) + EPS);
          if ((lane >> 4) == g) { const int cl = (lane & 15) * 8;
              f32x4 o0, o1; o0.x = x[0] * rstd * g0.x + b0.x; o0.y = x[1] * rstd * g0.y + b0.y; o0.z = x[2] * rstd * g0.z + b0.z; o0.w = x[3] * rstd * g0.w + b0.w;
              o1.x = x[4] * rstd * g1.x + b1.x; o1.y = x[5] * rstd * g1.y + b1.y; o1.z = x[6] * rstd * g1.z + b1.z; o1.w = x[7] * rstd * g1.w + b1.w;
              *(LAS f32x4*)(Vl + s * 128 + cl) = o0; *(LAS f32x4*)(Vl + s * 128 + cl + 4) = o1; } } }
    __syncthreads();
    {
        const int t = tid >> 2, cq = tid & 3, row = row0 + t;
        f32x4 acc[8];
#pragma unroll
        for (int i = 0; i < 8; ++i) acc[i] = (f32x4){0.f, 0.f, 0.f, 0.f};
        const int s4max = (F.wave * 16 + 15) >> 2;
        for (int s4 = 0; s4 <= s4max; ++s4) {
            const f32x4 w4 = *(const LAS f32x4*)(Wl + t * 132 + 4 * s4);
#pragma unroll
            for (int ss = 0; ss < 4; ++ss) { const float wv = w4[ss]; const LAS float* vr = Vl + (4 * s4 + ss) * 128 + cq * 4;
#pragma unroll
                for (int i = 0; i < 8; ++i) acc[i] = acc[i] + *(const LAS f32x4*)(vr + 16 * i) * wv; }
        }
        const float bias = A.in[IN_SGUB][((size_t)l * 4 + g) * 128 + t];
        const bf16* up = Z + (size_t)row * ZP + ZC_G + g * 128 + cq * 4; bf16* o = MIX + (size_t)row * DM + D_POOL + D_ATTN + g * 128 + cq * 4;
#pragma unroll
        for (int i = 0; i < 8; ++i) { const v2u uu = *(const GAS v2u*)(up + 16 * i); const f32x4 mx = acc[i] + bias;
            v2u w; w.x = pk2(bflo(uu.x) * mx.x, bfhi(uu.x) * mx.y); w.y = pk2(bflo(uu.y) * mx.z, bfhi(uu.y) * mx.w); *(GAS v2u*)(o + 16 * i) = w; }
    }
    __syncthreads();
}
__device__ __forceinline__ void idx_phase(Frame& F) {
    constexpr int SPB = 64 * 65 / 2, T = BATCH * SPB;
    const int s_lo = (int)(((long)F.vcu * T) / F.G), s_hi = (int)(((long)(F.vcu + 1) * T) / F.G);
    if (s_lo >= s_hi) return;
    const bf16* Z = (const bf16*)(F.ws + WS_Z); float* SC = (float*)(F.ws + WS_SC);
    const int tid = F.tid, lane = F.lane, r = lane & 31, h = lane >> 5;
    int b = s_lo / SPB, rem = s_lo - b * SPB, j = 0;
    while ((j + 1) * (j + 2) / 2 <= rem) ++j;
    int kt = rem - j * (j + 1) / 2;
    LAS unsigned char* Kl = F.lds;
    const int skey = tid >> 3, schunk = tid & 7, swoff = skey * 128 + ((schunk ^ ((skey >> 1) & 7)) << 4);
    int roff[4];
#pragma unroll
    for (int ks = 0; ks < 4; ++ks) roff[ks] = r * 128 + (((2 * ks + h) ^ ((r >> 1) & 7)) << 4);
    v4u stg = *(const GAS v4u*)(Z + (size_t)(b * SEQ + kt * 64 + skey) * ZP + ZC_KI + schunk * 8);
    *(LAS v4u*)(Kl + swoff) = stg;
    __syncthreads();
    int cur = 0, loaded = -1;
    bf16x8 A[4][4]; float wv[4][16];
    for (int s = s_lo; s < s_hi; ++s) {
        if (b * 64 + j != loaded) {
            loaded = b * 64 + j;
#pragma unroll
            for (int p = 0; p < 4; ++p) {
                const int qa = b * SEQ + j * 64 + F.wave * 8 + 2 * p + ((r >> 2) & 1), head = (r & 3) + 4 * (r >> 3);
#pragma unroll
                for (int ks = 0; ks < 4; ++ks) A[p][ks] = *(const GAS bf16x8*)(Z + (size_t)qa * ZP + ZC_QI + head * 64 + 16 * ks + 8 * h);
                const int qw = b * SEQ + j * 64 + F.wave * 8 + 2 * p + h;
                float w0[8], w1[8]; unpack8(*(const GAS v4u*)(Z + (size_t)qw * ZP + ZC_WI), w0); unpack8(*(const GAS v4u*)(Z + (size_t)qw * ZP + ZC_WI + 8), w1);
#pragma unroll
                for (int k = 0; k < 8; ++k) { wv[p][k] = w0[k] * 0.03125f; wv[p][8 + k] = w1[k] * 0.03125f; }
            }
        }
        int nb = b, nj = j, nkt = kt + 1;
        if (nkt > nj) { nkt = 0; ++nj; if (nj == 64) { nj = 0; ++nb; } }
        const bool has_next = s + 1 < s_hi;
        if (has_next) stg = *(const GAS v4u*)(Z + (size_t)(nb * SEQ + nkt * 64 + skey) * ZP + ZC_KI + schunk * 8);
#pragma unroll
        for (int kb = 0; kb < 2; ++kb) {
            bf16x8 Bf[4];
#pragma unroll
            for (int ks = 0; ks < 4; ++ks) Bf[ks] = *(const LAS bf16x8*)(Kl + cur * 8192 + kb * 4096 + roff[ks]);
#pragma unroll
            for (int p = 0; p < 4; ++p) {
                f32x16 acc = {};
#pragma unroll
                for (int ks = 0; ks < 4; ++ks) acc = __builtin_amdgcn_mfma_f32_32x32x16_bf16(A[p][ks], Bf[ks], acc, 0, 0, 0);
                float sc = 0.f;
#pragma unroll
                for (int i = 0; i < 16; ++i) sc += wv[p][i] * fmaxf(acc[i], 0.f);
                const int q = j * 64 + F.wave * 8 + 2 * p + h;
                SC[(size_t)(b * SEQ + q) * SEQ + kt * 64 + kb * 32 + r] = sc;
            }
        }
        if (has_next) *(LAS v4u*)(Kl + (cur ^ 1) * 8192 + swoff) = stg;
        __syncthreads();
        cur ^= 1; b = nb; j = nj; kt = nkt;
    }
}
__device__ __forceinline__ int wave_isum(int v) {
#pragma unroll
    for (int o = 1; o < 64; o <<= 1) v += __shfl_xor(v, o);
    return v;
}
__device__ __forceinline__ void select_phase(Frame& F) {
    const float* SC = (const float*)(F.ws + WS_SC); unsigned long long* MASKT = (unsigned long long*)(F.ws + WS_MASK);
    LAS unsigned long long* Ml = (LAS unsigned long long*)F.lds;
    const int lane = F.lane;
    for (int pr = F.vcu; pr < M / 32; pr += F.G) {
#pragma unroll 1
        for (int gq = 0; gq < 4; ++gq) {
            const int gi = gq >> 1, qi = gq & 1, grp = gi ? (M / 16 - 1 - pr) : pr;
            const int ql = F.wave * 2 + qi, row = grp * 16 + ql, t = row & (SEQ - 1), jmax = (t >> 6) + 1;
            const float* sr = SC + (size_t)row * SEQ + lane;
            const int nq = (jmax + 15) >> 4;
            unsigned u[64];
#pragma unroll
            for (int q = 0; q < 4; ++q) {
                if (q < nq) {
#pragma unroll
                    for (int jj = 0; jj < 16; ++jj) u[16 * q + jj] = __float_as_uint(sr[64 * (16 * q + jj)]);
                } else {
#pragma unroll
                    for (int jj = 0; jj < 16; ++jj) u[16 * q + jj] = 0xff800000u;
                }
            }
#pragma unroll
            for (int j = 0; j < 64; ++j) { const unsigned bits = u[j]; const unsigned key = (bits & 0x80000000u) ? ~bits : (bits | 0x80000000u); u[j] = (64 * j + lane <= t) ? key : 0u; }
            unsigned T = 1u; bool exact = true;
            if (t + 1 > TOPK) {
                T = 0u; exact = false;
                for (int bit = 31; bit >= 0; --bit) {
                    const unsigned cand = T | (1u << bit); int c = 0;
#pragma unroll
                    for (int q = 0; q < 4; ++q) if (q < nq) {
#pragma unroll
                        for (int jj = 0; jj < 16; ++jj) { c += __popcll(__ballot(u[16 * q + jj] >= cand)); if ((jj & 3) == 3) __builtin_amdgcn_sched_barrier(0); } }
                    if (c >= TOPK) { T = cand; if (c == TOPK) { exact = true; break; } }
                }
            }
            int need = 0;
            if (!exact) { int c = 0;
#pragma unroll
                for (int q = 0; q < 4; ++q) if (q < nq) {
#pragma unroll
                    for (int jj = 0; jj < 16; ++jj) { c += __popcll(__ballot(u[16 * q + jj] > T)); if ((jj & 3) == 3) __builtin_amdgcn_sched_barrier(0); } }
                need = TOPK - c; }
            unsigned mlo = 0u, mhi = 0u;
#pragma unroll
            for (int j = 0; j < 64; ++j) {
                unsigned long long wd = 0ull;
                if (j < jmax) {
                    if (exact) wd = __ballot(u[j] >= T);
                    else { wd = __ballot(u[j] > T); unsigned long long me = __ballot(u[j] == T);
                        if (me != 0ull && need > 0) { int pc = __popcll(me);
                            if (pc > need) { unsigned long long keep = 0ull; for (int k = 0; k < need; ++k) { const unsigned long long low = me & (0ull - me); keep |= low; me ^= low; } me = keep; pc = need; }
                            wd |= me; need -= pc; } }
                }
                { const unsigned wl_ = (unsigned)wd, wh_ = (unsigned)(wd >> 32); asm volatile("v_writelane_b32 %0, %2, %4\n\tv_writelane_b32 %1, %3, %4" : "+v"(mlo), "+v"(mhi) : "s"(wl_), "s"(wh_), "i"(j)); }
                if ((j & 3) == 3) __builtin_amdgcn_sched_barrier(0);
            }
            Ml[(gi * 16 + ql) * 64 + lane] = ((unsigned long long)mhi << 32) | mlo;
        }
        __syncthreads();
        { const int tid = F.tid, gi = tid >> 8, j = (tid >> 2) & 63, q4 = (tid & 3) * 4, grp = gi ? (M / 16 - 1 - pr) : pr, row = grp * 16 + q4, bb = row >> 12, t0 = row & (SEQ - 1);
          unsigned long long w0 = Ml[(gi * 16 + q4 + 0) * 64 + j], w1 = Ml[(gi * 16 + q4 + 1) * 64 + j], w2 = Ml[(gi * 16 + q4 + 2) * 64 + j], w3 = Ml[(gi * 16 + q4 + 3) * 64 + j];
          unsigned long long* dst = MASKT + ((size_t)bb * 64 + j) * SEQ + t0;
          typedef unsigned long long u64x2 __attribute__((ext_vector_type(2)));
          *(GAS u64x2*)dst = (u64x2){w0, w1}; *(GAS u64x2*)(dst + 2) = (u64x2){w2, w3}; }
        __syncthreads();
    }
}
__device__ __forceinline__ att::BlockRef attn_ref(int item, int pass) {
    const int bh = item >> 3, x = item & 7, bb = bh >> 3, hh = bh & 7, qb = pass ? 15 - x : x, P0 = qb * 256; const unsigned row0 = (unsigned)(bb * SEQ + P0);
    att::BlockRef r;
    r.qo = (row0 * ZP + ZC_Q + hh * HD) * 2u; r.ko = ((unsigned)(bb * SEQ) * ZP + ZC_K + hh * HD) * 2u; r.vo = ((unsigned)(bb * SEQ) * ZP + ZC_V + hh * HD) * 2u;
    r.oo = (row0 * DM + D_POOL + hh * HD) * 2u; r.mo = ((unsigned)(bb * 64) * SEQ + P0) * 8u; r.P0 = P0;
    return r;
}
__device__ __forceinline__ void attn_phase(Frame& F, char* lds) {
    constexpr int NITEMS = BATCH * NH * 8;
    if (F.vcu & 1) return;
    int L = F.vcu >> 1; const int stride = F.G >> 1 > 0 ? F.G >> 1 : 1;
    if (L >= NITEMS) return;
    att::Res R;
    R.z = __builtin_amdgcn_make_buffer_rsrc((void*)(F.ws + WS_Z), 0, (int)((size_t)M * ZP * 2), 0x00020000);
    R.mix = __builtin_amdgcn_make_buffer_rsrc((void*)(F.ws + WS_MIX), 0, (int)((size_t)M * DM * 2), 0x00020000);
    R.mk = __builtin_amdgcn_make_buffer_rsrc((void*)(F.ws + WS_MASK), 0, (int)((size_t)BATCH * 64 * SEQ * 8), 0x00020000);
    int pass = 0;
    att::BlockRef cur = attn_ref(L, 0);
    att::Seam S;
    att::prime(R, cur, lds, S);
    for (;;) {
        const bool more_pass = pass == 0, more_item = L + stride < NITEMS, last = !more_pass && !more_item;
        int passn = pass + 1, Ln = L;
        if (!more_pass) { passn = 0; Ln = more_item ? L + stride : L; }
        const att::BlockRef nxt = last ? cur : attn_ref(Ln, passn);
        att::block(R, cur, nxt, lds, S);
        if (last) break;
        cur = nxt; pass = passn; L = Ln;
    }
}

constexpr int N_PHASES = 1 + 6 * 2 * DEPTH;
__host__ __device__ inline bool phase_exists(int ph) { if (ph == 0) return true; const int r = (ph - 1) % 6, hl = (ph - 1) / 6; return !((hl & 1) && (r == 2 || r == 3)); }

__global__ void __launch_bounds__(NWAVES * 64, 2) mega(Args args) {
    extern __shared__ __attribute__((aligned(16))) unsigned char lds[];
    Frame F;
    F.lds = (LAS unsigned char*)lds;
    F.MISC = (volatile LAS unsigned*)(F.lds + LDSCTL_OFF);
    F.tid = threadIdx.x; F.lane = F.tid & 63; F.wave = __builtin_amdgcn_readfirstlane(F.tid >> 6);
    F.G = gridDim.x; { const int bx = blockIdx.x; F.vcu = (F.G % 8 == 0) ? (bx % 8) * (F.G / 8) + bx / 8 : bx; }
    F.ws = args.ws; F.out = args.out; F.ctl = (gu32*)(args.ws + WS_CTL);
    for (int u = F.tid; u < (LDS_BYTES - LDSCTL_OFF) / 4; u += NWAVES * 64) ((LAS unsigned*)(F.lds + LDSCTL_OFF))[u] = 0u;
    __syncthreads();
    const int lo = args.ph_lo, hi = args.ph_hi;
    XcdBarrier bar; bar.bar = (unsigned*)(F.ctl + CW_BAR); bar.x = 0; bar.st = F.MISC + 8;
    if (hi - lo > 1) bar = xcd_barrier_post((unsigned*)(F.ctl + CW_BAR), F.MISC + 8);
#define IN(k) (lo <= (k) && (k) < hi)
#define SEAM(k) do { if (IN(k) && IN((k) + 1)) xcd_barrier(bar); } while (0)
#ifdef PROBE_MASK
#define PB_BEGIN(kind) unsigned long long pb_t0_ = ((PROBE_MASK >> (kind)) & 1) ? __builtin_amdgcn_s_memrealtime() : 0ull
#define PB_END(kind) do { if ((PROBE_MASK >> (kind)) & 1) { const unsigned long long t1_ = __builtin_amdgcn_s_memrealtime(), d_ = t1_ - pb_t0_; while (__builtin_amdgcn_s_memrealtime() - t1_ < d_) __builtin_amdgcn_s_sleep(8); } } while (0)
#else
#define PB_BEGIN(kind) do {} while (0)
#define PB_END(kind) do {} while (0)
#endif

    #if !defined(ONLY) || ONLY==0
    if (IN(0)) { PB_BEGIN(0); refresh(F); p0_weights(F, args); p0_rows(F, args); PB_END(0); }
#endif
    SEAM(0);

    for (int hl = 0; hl < 2 * DEPTH; ++hl) {
        { unsigned long long w_ = (unsigned long long)args.ws; asm volatile("" : "+s"(w_)); F.ws = (unsigned char*)(GAS unsigned char*)w_; }
        const int l = hl >> 1, ffn = hl & 1, pb = 1 + 6 * hl;
#if !defined(ONLY) || ONLY==1
        if (IN(pb + 0)) {
            pg8::Gemm g; g.A = (const bf16*)(F.ws + WS_XB); g.M = M; g.K = DM;
            pg8::EpiRowScaleBf16 E; E.rs = (const float*)(F.ws + WS_RS);
            if (!ffn) { g.Bt = (const bf16*)(F.ws + WS_WIN + l * SZ_WIN); g.N = ZP; E.O = (bf16*)(F.ws + WS_Z); E.ldc = ZP; E.gelu_pn0 = GELU_PN0; }
            else { g.Bt = (const bf16*)(F.ws + WS_WUP + l * SZ_WUP); g.N = D_UP; E.O = (bf16*)(F.ws + WS_UP); E.ldc = D_UP; E.gelu_pn0 = 1 << 30; }
            pg8::StaticOrder S; S.init(g.M, g.N, F.G, (int)blockIdx.x);
            PB_BEGIN(1 + ffn);
            pg8::gemm_phase<pg8::EpiRowScaleBf16, pg8::StaticOrder, true, true>(F.lds, g, S, E);
            PB_END(1 + ffn);
        }
#endif
        SEAM(pb + 0);
        if (IN(pb + 1)) {
            PB_BEGIN(3 + ffn);
            refresh(F);
            if (!ffn) {
#if !defined(ONLY) || ONLY==2
                for (int it = F.vcu; it < 4 * (M / 64); it += F.G) pool_item(F, args, l, it);
#endif
#if !defined(ONLY) || ONLY==3
                for (int it = F.vcu; it < 4 * (M / CHUNK); it += F.G) gmlp_item(F, args, l, it);
#endif
#if !defined(ONLY) || ONLY==4
                idx_phase(F);
#endif
            } else {
#if !defined(ONLY) || ONLY==5
                conv_phase(F, args, l);
#endif
            }
            PB_END(3 + ffn);
        }
        SEAM(pb + 1);
        if (!ffn) {
#if !defined(ONLY) || ONLY==6
            if (IN(pb + 2)) { PB_BEGIN(5); refresh(F); select_phase(F); PB_END(5); }
#endif
            SEAM(pb + 2);
#if !defined(ONLY) || ONLY==7
            if (IN(pb + 3)) { PB_BEGIN(6); refresh(F); attn_phase(F, (char*)lds); PB_END(6); }
#endif
            SEAM(pb + 3);
        }
#if !defined(ONLY) || ONLY==8
        if (IN(pb + 4)) {
            pg8::Gemm g; g.M = M; g.N = DM;
            if (!ffn) { g.A = (const bf16*)(F.ws + WS_MIX); g.Bt = (const bf16*)(F.ws + WS_WOUT + l * SZ_WOUT); g.K = DM; }
            else { g.A = (const bf16*)(F.ws + WS_G); g.Bt = (const bf16*)(F.ws + WS_WDN + l * SZ_WDN); g.K = D_FF; }
            pg8::EpiF32 E; E.C = (float*)(F.ws + WS_F32); E.ldc = DM;
            pg8::StaticOrder S; S.init(g.M, g.N, F.G, (int)blockIdx.x);
            PB_BEGIN(7 + ffn);
            pg8::gemm_phase<pg8::EpiF32, pg8::StaticOrder, true, true>(F.lds, g, S, E);
            PB_END(7 + ffn);
        }
#endif
        SEAM(pb + 4);
#if !defined(ONLY) || ONLY==9
        if (IN(pb + 5)) {
            refresh(F);
            const float* xin = (hl == 0) ? args.in[IN_X] : (const float*)F.out;
            const float* gp = (ffn ? args.in[IN_NQF] : args.in[IN_NQM]) + (size_t)l * DM;
            PB_BEGIN(9);
            thin_phase(F, (const float*)(F.ws + WS_F32), xin, F.out, gp);
            PB_END(9);
        }
#endif
        SEAM(pb + 5);
    }
#undef IN
#undef SEAM
}

extern "C" void kernel_launch(void* const* d_in, const int* in_sizes, int n_in, void* d_out, int out_size, void* d_ws, size_t ws_size, hipStream_t stream) {
    static int grid = 0;
    if (grid == 0) {
        if (n_in != 17 || in_sizes[0] != M * DM || out_size != M * DM || ws_size < WS_END) {
            fprintf(stderr, "kernel_launch: built for 17 inputs, x/out of %d floats, >= %zu bytes of workspace; got n_in %d, in0 %d, out %d, ws %zu; nothing launched\n", M * DM, (size_t)WS_END, n_in, n_in > 0 ? in_sizes[0] : -1, out_size, ws_size);
            grid = -1; return; }
        int dev = 0, cus = 0, per_cu = 0;
        if (hipGetDevice(&dev) != hipSuccess || hipDeviceGetAttribute(&cus, hipDeviceAttributeMultiprocessorCount, dev) != hipSuccess) { fprintf(stderr, "kernel_launch: device query failed\n"); grid = -1; return; }
        if (hipFuncSetAttribute((const void*)mega, hipFuncAttributeMaxDynamicSharedMemorySize, LDS_BYTES) != hipSuccess) { fprintf(stderr, "kernel_launch: hipFuncSetAttribute failed\n"); grid = -1; return; }
        if (hipOccupancyMaxActiveBlocksPerMultiprocessor(&per_cu, (const void*)mega, NWAVES * 64, LDS_BYTES) != hipSuccess || per_cu < 1) {
            fprintf(stderr, "kernel_launch: occupancy query reports %d workgroups per CU\n", per_cu); per_cu = 1; }
        (void)hipGetLastError();
        grid = cus;
    }
    if (grid < 0) return;
    if (hipMemsetAsync((char*)d_ws + WS_CTL, 0, CTL_ZERO_BYTES, stream) != hipSuccess) { fprintf(stderr, "kernel_launch: memset failed\n"); return; }
    Args a{};
    for (int i = 0; i < 17; ++i) a.in[i] = (const float*)d_in[i];
    a.out = (float*)d_out; a.ws = (unsigned char*)d_ws;
#if MK_MULTI
    for (int ph = 0; ph < N_PHASES; ++ph) {
        if (!phase_exists(ph)) continue;
        a.ph_lo = ph; a.ph_hi = ph + 1;
        hipLaunchKernelGGL(mega, dim3(grid), dim3(NWAVES * 64), LDS_BYTES, stream, a);
    }
#else
    a.ph_lo = 0; a.ph_hi = N_PHASES;
    hipLaunchKernelGGL(mega, dim3(grid), dim3(NWAVES * 64), LDS_BYTES, stream, a);
#endif
    const hipError_t le = hipPeekAtLastError();
    if (le != hipSuccess) fprintf(stderr, "kernel_launch: launch failed: %s\n", hipGetErrorName(le));
}
```
